# Optimizing an MI355X kernel written in HIP

```python
import jax, jax.numpy as jnp
from jax import lax
import numpy as np

D_MODEL = 1024
BATCH = 32
SEQ = 256
DEPTH = 1
DEC_BATCH = 8
DEC_SEQ = 2048
PAST_LEN = 512

GRID_W = 64
H_RET = 4
DK_RET = 64
DV_RET = 128
H_GLA = 4
DK_GLA = 64
DV_GLA = 128
GLA_RANK = 16
GLA_TAU = 16.0
CHUNK = 64
ROPE_BASE = 10000.0
EPS = 1e-6
QK_RET = H_RET * DK_RET
W_RET = H_RET * DV_RET
QK_GLA = H_GLA * DK_GLA
W_GLA = H_GLA * DV_GLA
D_MIX = W_RET + W_GLA
D_IN_PROJ = 2 * QK_RET + 2 * W_RET + 2 * QK_GLA + 2 * W_GLA + 2 * GLA_RANK

kernel_name = "hybrid_retention_gla_diffusion_step"


def rms_norm(x):
    xf = x.astype(jnp.float32)
    return (xf * lax.rsqrt(jnp.mean(xf * xf, axis=-1, keepdims=True) + EPS)).astype(x.dtype)


def modulation(cond, w_mod, b_mod):
    m = jax.nn.silu(cond) @ w_mod + b_mod
    shift, scale, gate = jnp.split(m, 3, axis=-1)
    return shift, scale, gate


def axial_rope(n_tokens):
    rows = n_tokens // GRID_W
    rr, cc = jnp.meshgrid(jnp.arange(rows), jnp.arange(GRID_W), indexing="ij")
    rr = rr.reshape(-1).astype(jnp.float32)
    cc = cc.reshape(-1).astype(jnp.float32)
    n_freq = DK_RET // 4
    inv = ROPE_BASE ** (-jnp.arange(n_freq, dtype=jnp.float32) / n_freq)
    ang = jnp.concatenate([rr[:, None] * inv, cc[:, None] * inv], axis=-1)
    return jnp.cos(ang), jnp.sin(ang)


def apply_rope(x, cos, sin):
    x1, x2 = jnp.split(x, 2, axis=-1)
    c = cos.astype(x.dtype)
    s = sin.astype(x.dtype)
    return jnp.concatenate([x1 * c - x2 * s, x2 * c + x1 * s], axis=-1)


def _split_heads(a, n_heads):
    B, T, W = a.shape
    return a.reshape(B, T, n_heads, W // n_heads).transpose(0, 2, 1, 3)


def _merge_heads(a):
    B, H, T, d = a.shape
    return a.transpose(0, 2, 1, 3).reshape(B, T, H * d)


def chunked_gated_recurrence(q, k, v, log_g, s0):
    f32 = jnp.float32
    B, H, T, dk = q.shape
    dv = v.shape[-1]
    n = T // CHUNK
    qc = q.astype(f32).reshape(B, H, n, CHUNK, dk)
    kc = k.astype(f32).reshape(B, H, n, CHUNK, dk)
    vc = v.astype(f32).reshape(B, H, n, CHUNK, dv)
    b = jnp.cumsum(log_g.astype(f32).reshape(B, H, n, CHUNK, dk), axis=3)
    b_last = b[:, :, :, -1:, :]
    q_dec = qc * jnp.exp(b)
    k_inv = kc * jnp.exp(-b)
    k_dec = kc * jnp.exp(b_last - b)
    lower = jnp.tril(jnp.ones((CHUNK, CHUNK), dtype=bool))
    scores = jnp.where(lower, jnp.einsum("bhnid,bhnjd->bhnij", q_dec, k_inv), 0.0)
    o_intra = jnp.einsum("bhnij,bhnje->bhnie", scores, vc)
    kv = jnp.einsum("bhncd,bhnce->bhnde", k_dec, vc)
    decay = jnp.exp(b_last[:, :, :, 0, :])

    def step(s, inp):
        dec_n, kv_n = inp
        return dec_n[..., None] * s + kv_n, s

    s_final, s_starts = lax.scan(step, s0.astype(f32),
                                 (jnp.moveaxis(decay, 2, 0), jnp.moveaxis(kv, 2, 0)))
    s_starts = jnp.moveaxis(s_starts, 0, 2)
    o_inter = jnp.einsum("bhncd,bhnde->bhnce", q_dec, s_starts)
    return (o_intra + o_inter).reshape(B, H, T, dv), s_final


def bidirectional_recurrence(q, k, v, log_g_fwd, log_g_bwd, s0_fwd, s0_bwd):
    o_f, s_f = chunked_gated_recurrence(q, k, v, log_g_fwd, s0_fwd)
    flip = lambda a: jnp.flip(a, axis=2)
    o_b, s_b = chunked_gated_recurrence(flip(q), flip(k), flip(v), flip(log_g_bwd), s0_bwd)
    return o_f + flip(o_b), s_f, s_b


def mixer_layer(x, shift, scale, gate, s_ret0, s_gla0, rope,
                w_in, ret_log_decay, gla_w_alpha, gla_b_alpha, gla_norm_w, w_out):
    f32 = jnp.float32
    dt = x.dtype
    h = rms_norm(x) * (1.0 + scale) + shift
    proj = h @ w_in
    widths = (QK_RET, QK_RET, W_RET, W_RET, QK_GLA, QK_GLA, W_GLA, W_GLA)
    points = []
    acc = 0
    for w in widths:
        acc += w
        points.append(acc)
    q_r, k_r, v_r, z_r, q_g, k_g, v_g, z_g, lr = jnp.split(proj, points, axis=-1)

    q_r = _split_heads(q_r, H_RET)
    k_r = _split_heads(k_r, H_RET) * (DK_RET ** -0.5)
    if rope is not None:
        cos, sin = rope
        q_r = apply_rope(q_r, cos, sin)
        k_r = apply_rope(k_r, cos, sin)
    v_r = _split_heads(v_r, H_RET)
    B, _, T, _ = q_r.shape
    ld = ret_log_decay.astype(f32)
    g_rf = jnp.broadcast_to(ld[0][None, :, None, None], (B, H_RET, T, DK_RET))
    g_rb = jnp.broadcast_to(ld[1][None, :, None, None], (B, H_RET, T, DK_RET))
    o_r, sr_f, sr_b = bidirectional_recurrence(q_r, k_r, v_r, g_rf, g_rb, s_ret0[:, 0], s_ret0[:, 1])
    mu = jnp.mean(o_r, axis=-1, keepdims=True)
    var = jnp.mean(jnp.square(o_r - mu), axis=-1, keepdims=True)
    o_r = (o_r - mu) * lax.rsqrt(var + EPS)
    o_r = _merge_heads(o_r).astype(dt) * jax.nn.silu(z_r)

    q_g = _split_heads(q_g, H_GLA) * (DK_GLA ** -0.5)
    k_g = _split_heads(k_g, H_GLA)
    v_g = _split_heads(v_g, H_GLA)
    lr_f, lr_b = jnp.split(lr, 2, axis=-1)

    def gla_log_gate(lr_d, w_a, b_a):
        logit = (lr_d @ w_a + b_a).astype(f32)
        return _split_heads(jax.nn.log_sigmoid(logit) / GLA_TAU, H_GLA)

    o_g, sg_f, sg_b = bidirectional_recurrence(
        q_g, k_g, v_g,
        gla_log_gate(lr_f, gla_w_alpha[0], gla_b_alpha[0]),
        gla_log_gate(lr_b, gla_w_alpha[1], gla_b_alpha[1]),
        s_gla0[:, 0], s_gla0[:, 1])
    o_g = o_g * lax.rsqrt(jnp.mean(o_g * o_g, axis=-1, keepdims=True) + EPS) * gla_norm_w.astype(f32)
    o_g = _merge_heads(o_g).astype(dt) * jax.nn.silu(z_g)

    out = jnp.concatenate([o_r, o_g], axis=-1) @ w_out
    y = x + gate * out
    return y, jnp.stack([sr_f, sr_b], axis=1), jnp.stack([sg_f, sg_b], axis=1)


def setup_inputs(seed: int = 0) -> dict:
    key = jax.random.key(seed)
    ks = jax.random.split(key, 16)
    f32 = jnp.float32
    base_decay = np.log(1.0 - 2.0 ** (-5.0 - np.arange(H_RET))).astype(np.float32)
    ret_log_decay = jnp.asarray(base_decay)[None, None, :] * jnp.exp(
        0.1 * jax.random.normal(ks[9], (DEPTH, 2, H_RET), f32))
    return {
        "x_prompt": jax.random.normal(ks[0], (BATCH, SEQ, D_MODEL), f32),
        "x_sample": jax.random.normal(ks[1], (DEC_BATCH, DEC_SEQ, D_MODEL), f32),
        "c": jax.random.normal(ks[2], (DEC_BATCH, D_MODEL), f32),
        "state_ret": 0.5 * jax.random.normal(ks[3], (DEC_BATCH, DEPTH, 2, H_RET, DK_RET, DV_RET), f32),
        "state_gla": 0.5 * jax.random.normal(ks[4], (DEC_BATCH, DEPTH, 2, H_GLA, DK_GLA, DV_GLA), f32),
        "c_ctx": jax.random.normal(ks[5], (D_MODEL,), f32),
        "w_mod": jax.random.normal(ks[6], (DEPTH, D_MODEL, 3 * D_MODEL), f32) * (D_MODEL ** -0.5),
        "b_mod": 0.01 * jax.random.normal(ks[7], (DEPTH, 3 * D_MODEL), f32),
        "w_in": jax.random.normal(ks[8], (DEPTH, D_MODEL, D_IN_PROJ), f32) * (D_MODEL ** -0.5),
        "ret_log_decay": ret_log_decay,
        "gla_w_alpha": jax.random.normal(ks[10], (DEPTH, 2, GLA_RANK, QK_GLA), f32) * (GLA_RANK ** -0.5),
        "gla_b_alpha": 0.01 * jax.random.normal(ks[11], (DEPTH, 2, QK_GLA), f32),
        "gla_norm_w": 1.0 + 0.05 * jax.random.normal(ks[12], (DEPTH, DV_GLA), f32),
        "w_out": jax.random.normal(ks[13], (DEPTH, D_MIX, D_MODEL), f32) * (D_MIX ** -0.5),
        "final_norm_w": 1.0 + 0.05 * jax.random.normal(ks[14], (D_MODEL,), f32),
    }


def reference(x_prompt, x_sample, c, state_ret, state_gla, c_ctx, w_mod, b_mod, w_in,
              ret_log_decay, gla_w_alpha, gla_b_alpha, gla_norm_w, w_out, final_norm_w):
    x = x_prompt
    B_ctx = x_prompt.shape[0]
    new_ret, new_gla = [], []
    for l in range(DEPTH):
        shift, scale, gate = modulation(c_ctx[None, :], w_mod[l], b_mod[l])
        z_ret = jnp.zeros((B_ctx, 2, H_RET, DK_RET, DV_RET), jnp.float32)
        z_gla = jnp.zeros((B_ctx, 2, H_GLA, DK_GLA, DV_GLA), jnp.float32)
        x, s_r, s_g = mixer_layer(x, shift, scale, gate, z_ret, z_gla, None,
                                  w_in[l], ret_log_decay[l], gla_w_alpha[l], gla_b_alpha[l],
                                  gla_norm_w[l], w_out[l])
        new_ret.append(s_r.astype(x_prompt.dtype))
        new_gla.append(s_g.astype(x_prompt.dtype))
    y_prompt = rms_norm(x) * final_norm_w
    new_state_ret = jnp.stack(new_ret, axis=1)
    new_state_gla = jnp.stack(new_gla, axis=1)

    rope = axial_rope(x_sample.shape[1])
    xs = x_sample
    for l in range(DEPTH):
        shift, scale, gate = modulation(c[:, None, :], w_mod[l], b_mod[l])
        xs, _, _ = mixer_layer(xs, shift, scale, gate, state_ret[:, l], state_gla[:, l], rope,
                               w_in[l], ret_log_decay[l], gla_w_alpha[l], gla_b_alpha[l],
                               gla_norm_w[l], w_out[l])
    y_sample = rms_norm(xs) * final_norm_w
    return (y_prompt, y_sample, new_state_ret, new_state_gla)
```

```cpp
#include <hip/hip_runtime.h>
#include <cstdio>

#ifndef MULTI_LAUNCH
#define MULTI_LAUNCH 0
#endif

typedef unsigned short u16;
typedef unsigned int u32;
using bf16x8 = __attribute__((ext_vector_type(8))) short;
using f32x4 = __attribute__((ext_vector_type(4))) float;

constexpr int NROWS = 24576;
constexpr int NCTX = 8192;
constexpr int NPROJ = 3104;
constexpr int LDS_BYTES = 73728;
constexpr size_t OFF_SR = (size_t)NROWS * 1024;
constexpr size_t OFF_SG = OFF_SR + 2097152;
constexpr float EPS = 1e-6f;

struct P {
  const float *x_prompt, *x_sample, *c, *state_ret, *state_gla, *c_ctx, *w_mod, *b_mod, *w_in, *ret_ld,
      *gla_wa, *gla_ba, *gla_nw, *w_out, *fnw;
  float* out;
  float* mod;
  float* rope;
  u16* wt_in;
  u16* wt_out;
  u16* h;
  u16* proj;
  u16* of;
  u16* ob;
  unsigned* bar;
  uint4* watab;
  float* rowss;
  unsigned* mcnt;
};

__device__ __forceinline__ u32 f2bf(float f) {
  u32 u = __float_as_uint(f);
  return (u + 0x7fffu + ((u >> 16) & 1u)) >> 16;
}
typedef __bf16 bf16x2_t __attribute__((ext_vector_type(2)));
typedef float f32x2_t __attribute__((ext_vector_type(2)));
__device__ __forceinline__ u32 pack2(float a, float b) {
  f32x2_t v = {a, b};
  bf16x2_t r = __builtin_convertvector(v, bf16x2_t);
  return *reinterpret_cast<u32*>(&r);
}
__device__ __forceinline__ float bflo(u32 w) { return __uint_as_float(w << 16); }
__device__ __forceinline__ float bfhi(u32 w) { return __uint_as_float(w & 0xffff0000u); }
__device__ __forceinline__ float wave_sum(float v) {
#pragma unroll
  for (int m = 32; m >= 1; m >>= 1) v += __shfl_xor(v, m, 64);
  return v;
}
__device__ __forceinline__ bf16x8 ldfrag(const char* base, int row, int c16, int sx) {
  return *reinterpret_cast<const bf16x8*>(base + row * 128 + ((c16 ^ sx) << 4));
}
__device__ __forceinline__ int opaque_tid() { int t = threadIdx.x; asm volatile("" : "+v"(t)); return t; }
#define MFMA(a, b, c) __builtin_amdgcn_mfma_f32_16x16x32_bf16(a, b, c, 0, 0, 0)

#define XB_TMO      128
#define XB_XCNT(j)  (256  + 64 * (j))
#define XB_XSUB(j)  (1280 + 64 * (j))
#define XB_XGEN(j)  (2304 + 64 * (j))
#define XB_TOP      3328
#define XB_TOPGEN   3392
#define XCD_BAR_WORDS 3456
#define XB_SPIN_CAP (1u << 18)
#define LAS __attribute__((address_space(3)))
__device__ __forceinline__ unsigned xb_ld(unsigned* p) { return __hip_atomic_load(p, __ATOMIC_RELAXED, __HIP_MEMORY_SCOPE_AGENT); }
__device__ __forceinline__ unsigned xb_add(unsigned* p, unsigned v) { return __hip_atomic_fetch_add(p, v, __ATOMIC_RELAXED, __HIP_MEMORY_SCOPE_AGENT); }
__device__ __forceinline__ unsigned xb_xcc_id() { return (unsigned)__builtin_amdgcn_s_getreg((3 << 11) | 20) & 0xFu; }
#define XB_SPIN(cond, bar) do { unsigned _sp = 0; while (cond) { __builtin_amdgcn_s_sleep(1); \
    if ((++_sp & 255u) == 0u) { if (xb_ld(&(bar)[XB_TMO])) break; if (_sp > XB_SPIN_CAP) { atomicAdd(&(bar)[XB_TMO], 1u); break; } } } } while (0)
struct XcdBarrier { unsigned* bar; unsigned x; volatile LAS unsigned* st; };
__device__ __forceinline__ XcdBarrier xcd_barrier_post(unsigned* bar, volatile LAS unsigned* st) {
  XcdBarrier b; b.bar = bar; b.x = xb_xcc_id(); b.st = st;
  if (threadIdx.x == 0) (void)xb_add(&bar[XB_XCNT(b.x)], 1u);
  return b;
}
__device__ __forceinline__ void xcd_barrier_complete(unsigned* bar, unsigned x, unsigned& nloc, unsigned& nx) {
  const unsigned G = gridDim.x * gridDim.y * gridDim.z;
  unsigned sum, cnt, mine, sp = 0u;
  for (;;) {
    sum = 0u; cnt = 0u; mine = 0u;
#pragma unroll
    for (unsigned j = 0; j < 16; ++j) { const unsigned c = xb_ld(&bar[XB_XCNT(j)]); sum += c; cnt += (c > 0u) ? 1u : 0u; mine = (j == x) ? c : mine; }
    if (sum == G) break;
    __builtin_amdgcn_s_sleep(1);
    if ((++sp & 255u) == 0u) { if (xb_ld(&bar[XB_TMO])) break; if (sp > XB_SPIN_CAP) { atomicAdd(&bar[XB_TMO], 1u); break; } }
  }
  nloc = mine > 0u ? mine : 1u; nx = cnt > 0u ? cnt : 1u;
}
__device__ __forceinline__ void xcd_barrier(const XcdBarrier& b) {
  asm volatile("s_waitcnt vmcnt(0)" ::: "memory");
  __syncthreads();
  if (threadIdx.x == 0) {
    unsigned* bar = b.bar;
    __builtin_amdgcn_s_waitcnt(0);
    const unsigned bx = xb_xcc_id();
    unsigned nloc = b.st[0], nx = b.st[1];
    if (nloc == 0u) { xcd_barrier_complete(bar, bx, nloc, nx); b.st[0] = nloc; b.st[1] = nx; }
    const unsigned old = xb_add(&bar[XB_XSUB(bx)], 1u);
    const unsigned gen = old / nloc;
    if (old + 1u == (gen + 1u) * nloc) {
      __builtin_amdgcn_fence(__ATOMIC_RELEASE, "agent");
      asm volatile("s_waitcnt vmcnt(0)" ::: "memory");
      const unsigned og = xb_add(&bar[XB_TOP], 1u);
      const unsigned tg = og / nx;
      if (og + 1u == (tg + 1u) * nx) xb_add(&bar[XB_TOPGEN], 1u);
      else XB_SPIN(xb_ld(&bar[XB_TOPGEN]) == tg, bar);
      __builtin_amdgcn_fence(__ATOMIC_ACQUIRE, "agent");
      xb_add(&bar[XB_XGEN(bx)], 1u);
      asm volatile("s_waitcnt vmcnt(0)" ::: "memory");
    } else {
      XB_SPIN(xb_ld(&bar[XB_XGEN(bx)]) == gen, bar);
      __builtin_amdgcn_fence(__ATOMIC_ACQUIRE, "agent");
      asm volatile("s_waitcnt vmcnt(0)" ::: "memory");
    }
  }
  __syncthreads();
}

__device__ __forceinline__ void group_barrier(unsigned* ctr, unsigned n) {
  asm volatile("s_waitcnt vmcnt(0)" ::: "memory");
  __syncthreads();
  if (threadIdx.x == 0) {
    __builtin_amdgcn_fence(__ATOMIC_RELEASE, "agent");
    asm volatile("s_waitcnt vmcnt(0)" ::: "memory");
    xb_add(ctr, 1u);
    unsigned sp = 0;
    while (xb_ld(ctr) < n) { __builtin_amdgcn_s_sleep(8); if (++sp > (1u << 20)) break; }
    __builtin_amdgcn_fence(__ATOMIC_ACQUIRE, "agent");
    asm volatile("s_waitcnt vmcnt(0)" ::: "memory");
  }
  __syncthreads();
}

__device__ __forceinline__ void transpose_tile(const float* __restrict__ src, u16* __restrict__ dst, const int N,
                                               const int kt, const int ntile, char* smem, const int lane, const int wid) {
  float* tile = (float*)smem;
  const int k0 = kt * 64, n0 = ntile * 64;
  for (int i = wid; i < 64; i += 4) {
    int n = n0 + lane;
    tile[i * 65 + lane] = (n < N) ? src[(size_t)(k0 + i) * N + n] : 0.f;
  }
  __syncthreads();
  for (int i = wid; i < 64; i += 4)
    dst[(size_t)(n0 + i) * 1024 + k0 + lane] = (u16)f2bf(tile[lane * 65 + i]);
  __syncthreads();
}

__device__ void phase0(const P& p, int bid, int nb, char* smem) {
  const int tid = opaque_tid(), lane = tid & 63, wid = tid >> 6;
  const int NIT = 384 + 800 + 256 + 2;
  for (int it = bid; it < NIT; it += nb) {
    if (it < 384) {
      const int cb = it % 48, kc = it / 48;
      float* s = (float*)smem;
      float* red = s + 9 * 128;
      for (int i = tid; i < 9 * 128; i += 256) {
        int ci = i >> 7, kk = i & 127;
        int k = kc * 128 + kk;
        float v = (ci == 0) ? p.c_ctx[k] : p.c[(ci - 1) * 1024 + k];
        s[i] = v / (1.f + __expf(-v));
      }
      __syncthreads();
      float acc[9];
#pragma unroll
      for (int ci = 0; ci < 9; ++ci) acc[ci] = 0.f;
      const int col = cb * 64 + lane;
      const float* wp = p.w_mod + (size_t)(kc * 128 + wid * 32) * 3072 + col;
#pragma unroll 8
      for (int kk = 0; kk < 32; ++kk) {
        float w = wp[(size_t)kk * 3072];
#pragma unroll
        for (int ci = 0; ci < 9; ++ci) acc[ci] += s[ci * 128 + wid * 32 + kk] * w;
      }
#pragma unroll
      for (int ci = 0; ci < 9; ++ci) red[(wid * 9 + ci) * 64 + lane] = acc[ci];
      __syncthreads();
      for (int i = tid; i < 9 * 64; i += 256) {
        int ci = i >> 6, l = i & 63;
        float v = red[(0 * 9 + ci) * 64 + l] + red[(1 * 9 + ci) * 64 + l] + red[(2 * 9 + ci) * 64 + l] +
                  red[(3 * 9 + ci) * 64 + l];
        if (kc == 0) v += p.b_mod[cb * 64 + l];
        atomicAdd(&p.mod[ci * 3072 + cb * 64 + l], v);
      }
      __syncthreads();
    } else if (it < 384 + 800) {
      const int j = it - 384;
      transpose_tile(p.w_in, p.wt_in, NPROJ, j / 50, j % 50, smem, lane, wid);
    } else if (it < 384 + 800 + 256) {
      const int j = it - 384 - 800;
      transpose_tile(p.w_out, p.wt_out, 1024, j >> 4, j & 15, smem, lane, wid);
    } else if (it == 384 + 800 + 256 + 1) {
      for (int i = tid; i < 2048; i += 256) {
        const int ln = i & 63, dt = (i >> 6) & 3, hh = (i >> 8) & 3, dir = i >> 10;
        const int l15_ = ln & 15, quad_ = ln >> 4;
        uint4 wv = make_uint4(0u, 0u, 0u, 0u);
        if (quad_ < 2) {
          const float* wp_ = p.gla_wa + (size_t)(dir * 16 + quad_ * 8) * 256 + hh * 64 + dt * 16 + l15_;
          wv = make_uint4(pack2(wp_[0], wp_[256]), pack2(wp_[512], wp_[768]), pack2(wp_[1024], wp_[1280]), pack2(wp_[1536], wp_[1792]));
        }
        p.watab[i] = wv;
      }
    } else {
      for (int i = tid; i < 1024; i += 256) {
        int pos = i >> 4, f = i & 15;
        float inv = powf(10000.f, -(float)f / 16.f);
        float ang = (float)pos * inv;
        p.rope[i] = cosf(ang);
        p.rope[1024 + i] = sinf(ang);
      }
    }
  }
}

__device__ void phase1(const P& p, int bid, int nb) {
  const int tid_ = opaque_tid();
  const int lane = tid_ & 63, wid = tid_ >> 6;
  const int nw = nb * 4;
  for (int r0 = bid * 4 + wid; r0 < NROWS / 2; r0 += nw) {
    const float* xr[2];
    int ci[2];
#pragma unroll
    for (int u = 0; u < 2; ++u) {
      const int row = r0 + u * (NROWS / 2);
      if (row < NCTX) { xr[u] = p.x_prompt + (size_t)row * 1024; ci[u] = 0; }
      else { xr[u] = p.x_sample + (size_t)(row - NCTX) * 1024; ci[u] = 1 + ((row - NCTX) >> 11); }
    }
    float4 v[2][4];
#pragma unroll
    for (int u = 0; u < 2; ++u)
#pragma unroll
      for (int i = 0; i < 4; ++i) v[u][i] = reinterpret_cast<const float4*>(xr[u])[lane + 64 * i];
#pragma unroll
    for (int u = 0; u < 2; ++u) {
      const int row = r0 + u * (NROWS / 2);
      float ss = 0.f;
#pragma unroll
      for (int i = 0; i < 4; ++i)
        ss += v[u][i].x * v[u][i].x + v[u][i].y * v[u][i].y + v[u][i].z * v[u][i].z + v[u][i].w * v[u][i].w;
      ss = wave_sum(ss);
      const float r = rsqrtf(ss * (1.f / 1024.f) + EPS);
      const float* md = p.mod + ci[u] * 3072;
#pragma unroll
      for (int i = 0; i < 4; ++i) {
        int col = (lane + 64 * i) * 4;
        float4 sh = *reinterpret_cast<const float4*>(md + col);
        float4 sc = *reinterpret_cast<const float4*>(md + 1024 + col);
        uint2 o;
        o.x = pack2(v[u][i].x * r * (1.f + sc.x) + sh.x, v[u][i].y * r * (1.f + sc.y) + sh.y);
        o.y = pack2(v[u][i].z * r * (1.f + sc.z) + sh.z, v[u][i].w * r * (1.f + sc.w) + sh.w);
        *reinterpret_cast<uint2*>(p.h + (size_t)row * 1024 + col) = o;
      }
    }
  }
}

template <int MODE>
__device__ void gemm_phase(const P& p, const int xcd, const int local, const int nlocal, char* smem, const int tmode,
                           const int mt_x = 0, const int nt_x = 0) {
  constexpr int NT = (MODE == 1) ? 25 : 8;
  const u16* A = p.h;
  const u16* B = (MODE == 1) ? p.wt_in : p.wt_out;
  const int tid = opaque_tid(), lane = tid & 63, wid = tid >> 6, wr = wid >> 1, wc = wid & 1;
  const int l15 = lane & 15, quad = lane >> 4, sx = (l15 >> 1) & 7;
  const int lrow = tid >> 3, lc16 = tid & 7;
  const int wofs = lrow * 128 + ((lc16 ^ ((lrow >> 1) & 7)) << 4);
  const int ntiles = (tmode == 0) ? 320 : (tmode == 1 ? 280 : (tmode == 2 ? 192 : local + 1));
  for (int t = local; t < ntiles; t += nlocal) {
    int nt, mt;
    if (tmode == 0) {
      const int mg = t / 160, r_ = t % 160, j_ = r_ >> 3;
      nt = (j_ < 8) ? j_ : (j_ < 16 ? j_ + 4 : j_ + 5);
      mt = 64 + xcd * 16 + mg * 8 + (r_ & 7);
    } else if (tmode == 1) {
      if (t < 200) { nt = t >> 3; mt = xcd * 8 + (t & 7); }
      else { const int u_ = t - 200, mg = u_ / 40, r_ = u_ % 40, j_ = r_ >> 3; nt = (j_ < 4) ? 8 + j_ : 20; mt = 64 + xcd * 16 + mg * 8 + (r_ & 7); }
    } else if (tmode == 2) {
      const int mg = t >> 6, r_ = t & 63;
      nt = r_ >> 3; mt = xcd * 24 + mg * 8 + (r_ & 7);
    } else {
      nt = nt_x; mt = mt_x;
    }
    const int m0 = mt * 128, n0 = nt * 128;
    f32x4 acc[4][4];
#pragma unroll
    for (int a = 0; a < 4; ++a)
#pragma unroll
      for (int b = 0; b < 4; ++b) acc[a][b] = (f32x4){0.f, 0.f, 0.f, 0.f};
    const u16* ag = A + (size_t)(m0 + lrow) * 1024 + lc16 * 8;
    const u16* bg = B + (size_t)(n0 + lrow) * 1024 + lc16 * 8;
    uint4 ra0, ra1, ra2, ra3, rb0, rb1, rb2, rb3;
    uint4 sa0, sa1, sa2, sa3, sb0, sb1, sb2, sb3;
#define GLOAD(R, S, ksv)                                                              \
  {                                                                                   \
    const u16* a_ = ag + (ksv) * 64;                                                  \
    const u16* b_ = bg + (ksv) * 64;                                                  \
    R##0 = *reinterpret_cast<const uint4*>(a_);                                       \
    R##1 = *reinterpret_cast<const uint4*>(a_ + 32 * 1024);                           \
    R##2 = *reinterpret_cast<const uint4*>(a_ + 64 * 1024);                           \
    R##3 = *reinterpret_cast<const uint4*>(a_ + 96 * 1024);                           \
    S##0 = *reinterpret_cast<const uint4*>(b_);                                       \
    S##1 = *reinterpret_cast<const uint4*>(b_ + 32 * 1024);                           \
    S##2 = *reinterpret_cast<const uint4*>(b_ + 64 * 1024);                           \
    S##3 = *reinterpret_cast<const uint4*>(b_ + 96 * 1024);                           \
  }
#define LWRITE(buf, R, S)                                                             \
  {                                                                                   \
    char* d_ = smem + (buf) * 32768 + wofs;                                           \
    *reinterpret_cast<uint4*>(d_) = R##0;                                             \
    *reinterpret_cast<uint4*>(d_ + 4096) = R##1;                                      \
    *reinterpret_cast<uint4*>(d_ + 8192) = R##2;                                      \
    *reinterpret_cast<uint4*>(d_ + 12288) = R##3;                                     \
    *reinterpret_cast<uint4*>(d_ + 16384) = S##0;                                     \
    *reinterpret_cast<uint4*>(d_ + 16384 + 4096) = S##1;                              \
    *reinterpret_cast<uint4*>(d_ + 16384 + 8192) = S##2;                              \
    *reinterpret_cast<uint4*>(d_ + 16384 + 12288) = S##3;                             \
  }
#define COMPUTE(buf)                                                                  \
  {                                                                                   \
    const char* cur = smem + (buf) * 32768;                                           \
    _Pragma("unroll") for (int kk = 0; kk < 2; ++kk) {                                \
      bf16x8 af[4], bfr[4];                                                           \
      _Pragma("unroll") for (int ns = 0; ns < 4; ++ns)                                \
          af[ns] = ldfrag(cur + 16384, wc * 64 + ns * 16 + l15, kk * 4 + quad, sx);   \
      _Pragma("unroll") for (int ms = 0; ms < 4; ++ms)                                \
          bfr[ms] = ldfrag(cur, wr * 64 + ms * 16 + l15, kk * 4 + quad, sx);          \
      _Pragma("unroll") for (int ns = 0; ns < 4; ++ns)                                \
          _Pragma("unroll") for (int ms = 0; ms < 4; ++ms)                            \
              acc[ns][ms] = MFMA(af[ns], bfr[ms], acc[ns][ms]);                       \
    }                                                                                 \
  }
    f32x4 xpre[4][4];
    GLOAD(ra, rb, 0);
    GLOAD(sa, sb, 1);
    LWRITE(0, ra, rb);
    __syncthreads();
#pragma unroll
    for (int ks = 0; ks < 16; ks += 2) {
      if (ks + 2 < 16) GLOAD(ra, rb, ks + 2);
      if (MODE == 2 && ks == 14) {
        const float* xb_ = (m0 < NCTX) ? p.x_prompt : (p.x_sample - (size_t)NCTX * 1024);
        const float* xp_ = xb_ + (size_t)(m0 + wr * 64 + l15) * 1024 + (n0 + wc * 64 + quad * 4);
#pragma unroll
        for (int ns = 0; ns < 4; ++ns)
#pragma unroll
          for (int ms = 0; ms < 4; ++ms) xpre[ns][ms] = *reinterpret_cast<const f32x4*>(xp_ + (size_t)ms * 16 * 1024 + ns * 16);
      }
      __builtin_amdgcn_sched_barrier(0);
      COMPUTE(0);
      LWRITE(1, sa, sb);
      __syncthreads();
      if (ks + 3 < 16) GLOAD(sa, sb, ks + 3);
      __builtin_amdgcn_sched_barrier(0);
      COMPUTE(1);
      if (ks + 2 < 16) LWRITE(0, ra, rb);
      __syncthreads();
    }
#undef GLOAD
#undef LWRITE
#undef COMPUTE
    const int colbase = n0 + wc * 64;
    if (MODE == 1) {
      if (colbase < NPROJ) {
        const bool sample = m0 >= NCTX;
        const bool scaled = (colbase >= 256 && colbase < 512) || (colbase >= 1536 && colbase < 1792);
        if (scaled) {
#pragma unroll
          for (int a = 0; a < 4; ++a)
#pragma unroll
            for (int b = 0; b < 4; ++b) acc[a][b] *= 0.125f;
        }
        if (sample && colbase < 512) {
#pragma unroll
          for (int ms = 0; ms < 4; ++ms) {
            int m = m0 + wr * 64 + ms * 16 + l15;
            int tkn = (m - NCTX) & 2047;
            int r = tkn >> 6, c = tkn & 63;
            f32x4 c0 = *reinterpret_cast<const f32x4*>(p.rope + r * 16 + quad * 4);
            f32x4 s0 = *reinterpret_cast<const f32x4*>(p.rope + 1024 + r * 16 + quad * 4);
            f32x4 c1 = *reinterpret_cast<const f32x4*>(p.rope + c * 16 + quad * 4);
            f32x4 s1 = *reinterpret_cast<const f32x4*>(p.rope + 1024 + c * 16 + quad * 4);
            f32x4 x1 = acc[0][ms], x2 = acc[2][ms];
            acc[0][ms] = x1 * c0 - x2 * s0;
            acc[2][ms] = x2 * c0 + x1 * s0;
            x1 = acc[1][ms]; x2 = acc[3][ms];
            acc[1][ms] = x1 * c1 - x2 * s1;
            acc[3][ms] = x2 * c1 + x1 * s1;
          }
        }
#pragma unroll
        for (int ns = 0; ns < 4; ++ns) {
          int n = colbase + ns * 16 + quad * 4;
          if (n < NPROJ) {
#pragma unroll
            for (int ms = 0; ms < 4; ++ms) {
              int m = m0 + wr * 64 + ms * 16 + l15;
              uint2 o;
              o.x = pack2(acc[ns][ms][0], acc[ns][ms][1]);
              o.y = pack2(acc[ns][ms][2], acc[ns][ms][3]);
              if (tmode == 3)
                __hip_atomic_store(reinterpret_cast<unsigned long long*>(p.proj + (size_t)m * NPROJ + n),
                                   ((unsigned long long)o.y << 32) | o.x, __ATOMIC_RELAXED, __HIP_MEMORY_SCOPE_AGENT);
              else
                *reinterpret_cast<uint2*>(p.proj + (size_t)m * NPROJ + n) = o;
            }
          }
        }
      }
    } else {
      const int ci = (m0 < NCTX) ? 0 : 1 + ((m0 - NCTX) >> 11);
      const float* gate = p.mod + ci * 3072 + 2048;
#pragma unroll
      for (int ns = 0; ns < 4; ++ns) {
        int n = colbase + ns * 16 + quad * 4;
        f32x4 g = *reinterpret_cast<const f32x4*>(gate + n);
#pragma unroll
        for (int ms = 0; ms < 4; ++ms) {
          acc[ns][ms] = xpre[ns][ms] + g * acc[ns][ms];
        }
      }
#pragma unroll
      for (int ms = 0; ms < 4; ++ms) {
        float ssq = 0.f;
#pragma unroll
        for (int ns = 0; ns < 4; ++ns)
#pragma unroll
          for (int j = 0; j < 4; ++j) ssq += acc[ns][ms][j] * acc[ns][ms][j];
        ssq += __shfl_xor(ssq, 16, 64);
        ssq += __shfl_xor(ssq, 32, 64);
        if (quad == 0)
          (void)__hip_atomic_fetch_add(p.rowss + m0 + wr * 64 + ms * 16 + l15, ssq, __ATOMIC_RELAXED, __HIP_MEMORY_SCOPE_AGENT);
      }
      asm volatile("s_waitcnt vmcnt(0)" ::: "memory");
      __syncthreads();
      if (tid == 0) {
        xb_add(p.mcnt + mt, 1u);
        unsigned sp = 0;
        while (xb_ld(p.mcnt + mt) < 8u) { __builtin_amdgcn_s_sleep(2); if (++sp > (1u << 22)) break; }
      }
      __syncthreads();
#pragma unroll
      for (int ms = 0; ms < 4; ++ms) {
        const int m = m0 + wr * 64 + ms * 16 + l15;
        const float ssr = __hip_atomic_load(p.rowss + m, __ATOMIC_RELAXED, __HIP_MEMORY_SCOPE_AGENT);
        const float rn = rsqrtf(ssr * (1.f / 1024.f) + EPS);
#pragma unroll
        for (int ns = 0; ns < 4; ++ns) {
          const int n = colbase + ns * 16 + quad * 4;
          const f32x4 fwv = *reinterpret_cast<const f32x4*>(p.fnw + n);
          *reinterpret_cast<f32x4*>(p.out + (size_t)m * 1024 + n) = acc[ns][ms] * rn * fwv;
        }
      }
    }
  }
}

__device__ __forceinline__ void stage_v(char* VT, const int tid, const uint4 RA, const uint4 RB, const int e8) {
  const int pp = tid & 31;
  const u32 a0[4] = {RA.x, RA.y, RA.z, RA.w};
  const u32 a1[4] = {RB.x, RB.y, RB.z, RB.w};
#pragma unroll
  for (int ei = 0; ei < 8; ++ei) {
    int e = e8 * 8 + ei;
    const u32 pk = __builtin_amdgcn_perm(a1[ei >> 1], a0[ei >> 1], (ei & 1) ? 0x07060302u : 0x05040100u);
    int ofs = e * 128 + (((pp >> 2) ^ ((e >> 1) & 7)) << 4) + (pp & 3) * 4;
    *reinterpret_cast<u32*>(VT + ofs) = pk;
  }
}
__device__ __forceinline__ void stage_ret_row(char* Qs, char* Ks, char* KdT, const int ofs, const int t, const int c16,
                                              const uint4 rq, const uint4 rk, const float b, const float kdsc) {
  const float eb = __expf(b);
  const float ei = __builtin_amdgcn_rcpf(eb);
  const float kd = ei * kdsc;
  const u32 qw[4] = {rq.x, rq.y, rq.z, rq.w};
  const u32 kw[4] = {rk.x, rk.y, rk.z, rk.w};
  u32 qo[4], ko[4];
  char* kcol = KdT + (c16 * 8) * 128 + (t & 7) * 2;
  const int tch = t >> 3;
#pragma unroll
  for (int i = 0; i < 4; ++i) {
    const float q0 = bflo(qw[i]), q1 = bfhi(qw[i]), k0 = bflo(kw[i]), k1 = bfhi(kw[i]);
    qo[i] = pack2(q0 * eb, q1 * eb);
    ko[i] = pack2(k0 * ei, k1 * ei);
    const u32 kdp = pack2(k0 * kd, k1 * kd);
    const int sw = ((tch ^ (((c16 & 1) << 2) | i)) << 4);
    *reinterpret_cast<u16*>(kcol + (2 * i) * 128 + sw) = (u16)(kdp & 0xffffu);
    *reinterpret_cast<u16*>(kcol + (2 * i + 1) * 128 + sw) = (u16)(kdp >> 16);
  }
  *reinterpret_cast<uint4*>(Qs + ofs) = make_uint4(qo[0], qo[1], qo[2], qo[3]);
  *reinterpret_cast<uint4*>(Ks + ofs) = make_uint4(ko[0], ko[1], ko[2], ko[3]);
}
__device__ __forceinline__ void stage_chunk(char* Qs, char* Ks, char* KdT, char* VT, char* LRb, const int tid, const uint4 rq0,
                                            const uint4 rq1, const uint4 rk0, const uint4 rk1, const uint4 rv0,
                                            const uint4 rv1, const uint4 rv2, const uint4 rv3, const uint4 rl,
                                            const bool ret, const int dir, const float ld) {
  const int tk = tid >> 3, c16 = tid & 7;
  const int ofs = tk * 128 + ((c16 ^ ((tk >> 1) & 7)) << 4);
  if (!ret) {
    *reinterpret_cast<uint4*>(Qs + ofs) = rq0;
    *reinterpret_cast<uint4*>(Ks + ofs) = rk0;
    *reinterpret_cast<uint4*>(Qs + ofs + 4096) = rq1;
    *reinterpret_cast<uint4*>(Ks + ofs + 4096) = rk1;
  } else {
    const float kdsc = __expf(64.f * ld);
    stage_ret_row(Qs, Ks, KdT, ofs, tk, c16, rq0, rk0, dir ? ld * (float)(64 - tk) : ld * (float)(tk + 1), kdsc);
    stage_ret_row(Qs, Ks, KdT, ofs + 4096, tk + 32, c16, rq1, rk1, dir ? ld * (float)(32 - tk) : ld * (float)(tk + 33), kdsc);
  }
  stage_v(VT, tid, rv0, rv1, tid >> 5);
  stage_v(VT, tid, rv2, rv3, (tid >> 5) + 8);
  (void)LRb; (void)rl;
}

__device__ __forceinline__ bool rec_is_heavy(int bid) { return bid < 128; }
__device__ __forceinline__ int rec_light_index(int bid) { return bid - 128; }

__device__ void rec_phase(const P& p, char* smem, const int item, unsigned* gate, const unsigned gate_target = 136u) {
  const int tid = opaque_tid(), lane = tid & 63, w = tid >> 6, l15 = lane & 15, quad = lane >> 4;
  const int sx = (l15 >> 1) & 7;
  char* Qs = smem;
  char* Ks = smem + 8192;
  char* KdT = smem + 16384;
  char* VT = smem + 24576;
  char* SC = smem + 40960;
  char* ST = smem + 49152;
  char* LRb = smem + 65536;
  float* TOT = (float*)(smem + 69632);
  float* DEC = (float*)(smem + 70656);

  for (int once_ = 0; once_ < 1; ++once_) {
    const int it = item;
    const bool sample = it < 128;
    const int id = sample ? it : it - 128;
    const int dir = id & 1, hg = (id >> 1) & 7, b = id >> 4;
    const int row0 = sample ? NCTX + b * 2048 : b * 256;
    const int nch = sample ? 32 : 4;
    const bool gla = hg >= 4;
    const int hh = hg & 3;
    const int qcol = gla ? 1536 + hh * 64 : hh * 64;
    const int kcol = gla ? 1792 + hh * 64 : 256 + hh * 64;
    const int vcol = gla ? 2048 + hh * 128 : 512 + hh * 128;
    const int lrcol = 3072 + dir * 16;
    u16* obuf = dir ? p.ob : p.of;

    bf16x8 wafr[4];
    float bav[4];
    float ld = 0.f;
#pragma unroll
    for (int dt = 0; dt < 4; ++dt) {
      wafr[dt] = (bf16x8){0, 0, 0, 0, 0, 0, 0, 0};
      bav[dt] = 0.f;
    }
    if (gla) {
      int lo2_ = hh * 64 + l15;
      asm volatile("" : "+v"(lo2_));
      const uint4* wt_ = p.watab + ((dir * 4 + hh) * 4) * 64 + lane;
#pragma unroll
      for (int dt = 0; dt < 4; ++dt) {
        bav[dt] = p.gla_ba[dir * 256 + lo2_ + dt * 16];
        uint4 wv = wt_[dt * 64];
        wafr[dt] = *reinterpret_cast<bf16x8*>(&wv);
      }
    } else {
      ld = p.ret_ld[dir * 4 + hh];
    }

    f32x4 S[4][2];
    if (sample) {
      int lo_ = quad * 512 + 32 * w + l15;
      asm volatile("" : "+v"(lo_));
      const float* sp = (gla ? p.state_gla : p.state_ret) + (size_t)((b * 2 + dir) * 4 + hh) * 8192 + lo_;
#pragma unroll
      for (int dt = 0; dt < 4; ++dt)
#pragma unroll
        for (int et = 0; et < 2; ++et)
#pragma unroll
          for (int jj = 0; jj < 4; ++jj)
            S[dt][et][jj] = sp[dt * 2048 + jj * 128 + et * 16];
    } else {
#pragma unroll
      for (int dt = 0; dt < 4; ++dt)
#pragma unroll
        for (int et = 0; et < 2; ++et) S[dt][et] = (f32x4){0.f, 0.f, 0.f, 0.f};
    }
#pragma unroll
    for (int dt = 0; dt < 4; ++dt)
#pragma unroll
      for (int et = 0; et < 2; ++et) {
        int e = 32 * w + et * 16 + l15, d0 = dt * 16 + quad * 4;
        uint2 o;
        o.x = pack2(S[dt][et][0], S[dt][et][1]);
        o.y = pack2(S[dt][et][2], S[dt][et][3]);
        *reinterpret_cast<uint2*>(ST + e * 128 + (((d0 >> 3) ^ sx) << 4) + (d0 & 7) * 2) = o;
      }

    uint4 rq0, rq1, rk0, rk1, rv0, rv1, rv2, rv3, rl;
    rl = make_uint4(0, 0, 0, 0);
    int c = dir ? nch - 1 : 0;
    const int cstep = dir ? -1 : 1;
    const u16* pq0 = p.proj + (size_t)(row0 + (tid >> 3)) * NPROJ + (tid & 7) * 8;
    const u16* pv0 = p.proj + (size_t)(row0 + 2 * (tid & 31)) * NPROJ + vcol + (tid >> 5) * 8;
    const u16* pl0 = p.proj + (size_t)(row0 + 16 * w + l15) * NPROJ + lrcol + (quad & 1) * 8;
#define PREFETCH(cc)                                                            \
  {                                                                             \
    const size_t co_ = (size_t)(cc) * 64 * NPROJ;                               \
    rq0 = *reinterpret_cast<const uint4*>(pq0 + co_ + qcol);                    \
    rk0 = *reinterpret_cast<const uint4*>(pq0 + co_ + kcol);                    \
    rq1 = *reinterpret_cast<const uint4*>(pq0 + co_ + 32 * NPROJ + qcol);       \
    rk1 = *reinterpret_cast<const uint4*>(pq0 + co_ + 32 * NPROJ + kcol);       \
    rv0 = *reinterpret_cast<const uint4*>(pv0 + co_);                           \
    rv1 = *reinterpret_cast<const uint4*>(pv0 + co_ + NPROJ);                   \
    rv2 = *reinterpret_cast<const uint4*>(pv0 + co_ + 64);                      \
    rv3 = *reinterpret_cast<const uint4*>(pv0 + co_ + 64 + NPROJ);              \
    rl = *reinterpret_cast<const uint4*>(pl0 + co_);                            \
  }
    float gv[4][4];
    float Eq[4];
    if (!gla && tid < 64) DEC[tid] = __expf(64.f * ld);
    if (gate != nullptr) {
      if (tid == 0) {
        unsigned sp = 0;
        while (xb_ld(gate) < gate_target) { __builtin_amdgcn_s_sleep(4); if (++sp > (1u << 22)) break; }
        __builtin_amdgcn_fence(__ATOMIC_ACQUIRE, "agent");
        asm volatile("s_waitcnt vmcnt(0)" ::: "memory");
      }
      __syncthreads();
    }
    PREFETCH(c);
    stage_chunk(Qs, Ks, KdT, VT, LRb, tid, rq0, rq1, rk0, rk1, rv0, rv1, rv2, rv3, rl, !gla, dir, ld);
    {
        if (gla) {
          bf16x8 afr = (bf16x8){0, 0, 0, 0, 0, 0, 0, 0};
          if (quad < 2) afr = *reinterpret_cast<const bf16x8*>(&rl);
#pragma unroll
          for (int dt = 0; dt < 4; ++dt) {
            f32x4 z = MFMA(afr, wafr[dt], ((f32x4){0.f, 0.f, 0.f, 0.f}));
#pragma unroll
            for (int j = 0; j < 4; ++j) {
              float zz = z[j] + bav[dt];
              gv[dt][j] = (fminf(zz, 0.f) - __logf(1.f + __expf(-fabsf(zz)))) * (1.f / 16.f);
            }
          }
#pragma unroll
          for (int dt = 0; dt < 4; ++dt) {
            gv[dt][1] += gv[dt][0];
            gv[dt][2] += gv[dt][1];
            gv[dt][3] += gv[dt][2];
            const float T = gv[dt][3];
            const float x1 = __shfl_up(T, 16, 64), x2 = __shfl_up(T, 32, 64), x3 = __shfl_up(T, 48, 64);
            const float E = (quad >= 1 ? x1 : 0.f) + (quad >= 2 ? x2 : 0.f) + (quad >= 3 ? x3 : 0.f);
            Eq[dt] = E;
            const float Wt = __shfl(E + T, 48 + l15, 64);
            if (quad == 0) TOT[w * 64 + dt * 16 + l15] = Wt;
          }
        } else {
#pragma unroll
          for (int dt = 0; dt < 4; ++dt) {
#pragma unroll
            for (int j = 0; j < 4; ++j) gv[dt][j] = ld * (float)(j + 1);
            Eq[dt] = ld * (float)(4 * quad);
          }
        }
    }
    __syncthreads();
    for (int s = 0; s < nch; ++s, c += cstep) {
      const int rb = row0 + c * 64;
      {
        const int cn_ = (s + 1 < nch) ? (c + cstep) : c;
        PREFETCH(cn_);
      }
      if (gla) {
      {
        int qofs = (16 * w + quad * 4) * 128 + (l15 & 7) * 2;
        asm volatile("" : "+v"(qofs));
        float ebs[4], eis[4], ebt = 1.f;
#pragma unroll
        for (int dt = 0; dt < 4; ++dt) {
          const int d = dt * 16 + l15;
          if (gla || dt == 0) {
            float btot, off;
            if (gla) {
              const float t0 = TOT[d], t1 = TOT[64 + d], t2 = TOT[128 + d], t3 = TOT[192 + d];
              btot = t0 + t1 + t2 + t3;
              off = (w > 0 ? t0 : 0.f) + (w > 1 ? t1 : 0.f) + (w > 2 ? t2 : 0.f);
            } else {
              btot = 64.f * ld;
              off = ld * (float)(16 * w);
            }
            ebt = __expf(btot);
            const float base = off + Eq[dt];
#pragma unroll
            for (int j = 0; j < 4; ++j) {
              const float exj = (j == 0) ? 0.f : gv[dt][j - 1];
              const float bb = dir ? (btot - base - exj) : (base + gv[dt][j]);
              ebs[j] = __expf(bb);
              eis[j] = __builtin_amdgcn_rcpf(ebs[j]);
            }
          }
          if (w == 0 && quad == 0) DEC[d] = ebt;
          float kdv[4];
#pragma unroll
          for (int j = 0; j < 4; ++j) {
            const float eb = ebs[j];
            const float ei = eis[j];
            const int ofs = qofs + j * 128 + (((dt * 2 + (l15 >> 3)) ^ (quad * 2 + (j >> 1))) << 4);
            const float q = __uint_as_float((u32)(*reinterpret_cast<const u16*>(Qs + ofs)) << 16);
            const float k = __uint_as_float((u32)(*reinterpret_cast<const u16*>(Ks + ofs)) << 16);
            const float ki = k * ei;
            const u32 pk = pack2(q * eb, ki);
            *reinterpret_cast<u16*>(Qs + ofs) = (u16)(pk & 0xffffu);
            *reinterpret_cast<u16*>(Ks + ofs) = (u16)(pk >> 16);
            kdv[j] = ki * ebt;
          }
          uint2 kd2;
          kd2.x = pack2(kdv[0], kdv[1]);
          kd2.y = pack2(kdv[2], kdv[3]);
          *reinterpret_cast<uint2*>(KdT + d * 128 + (((2 * w + (quad >> 1)) ^ ((d >> 1) & 7)) << 4) + (quad & 1) * 8) = kd2;
        }
      }
      __syncthreads();
      }
      {
        f32x4 sacc[4];
#pragma unroll
        for (int jt = 0; jt < 4; ++jt) sacc[jt] = (f32x4){0.f, 0.f, 0.f, 0.f};
        int irow = 16 * w + l15;
        asm volatile("" : "+v"(irow));
        const int sgn = dir ? -1 : 1;
#pragma unroll
        for (int kk = 0; kk < 2; ++kk) {
          bf16x8 bq = ldfrag(Qs, irow, kk * 4 + quad, sx);
#pragma unroll
          for (int jt = 0; jt < 4; ++jt) {
            bf16x8 ak = ldfrag(Ks, jt * 16 + l15, kk * 4 + quad, sx);
            sacc[jt] = MFMA(ak, bq, sacc[jt]);
          }
        }
#pragma unroll
        for (int jt = 0; jt < 4; ++jt) {
          const int j0 = jt * 16 + quad * 4;
          float v[4];
          const int rel_ = (jt - w) * sgn;
          if (rel_ < 0) {
#pragma unroll
            for (int jj = 0; jj < 4; ++jj) v[jj] = sacc[jt][jj];
          } else if (rel_ > 0) {
#pragma unroll
            for (int jj = 0; jj < 4; ++jj) v[jj] = 0.f;
          } else {
#pragma unroll
            for (int jj = 0; jj < 4; ++jj) {
              int j = j0 + jj;
              bool keep = (j - irow) * sgn <= 0;
              v[jj] = keep ? sacc[jt][jj] : 0.f;
            }
          }
          uint2 o;
          o.x = pack2(v[0], v[1]);
          o.y = pack2(v[2], v[3]);
          *reinterpret_cast<uint2*>(SC + irow * 128 + (((j0 >> 3) ^ sx) << 4) + (j0 & 7) * 2) = o;
        }
      }
      __syncthreads();
      {
        f32x4 o[2][4];
#pragma unroll
        for (int et = 0; et < 2; ++et)
#pragma unroll
          for (int i4 = 0; i4 < 4; ++i4) o[et][i4] = (f32x4){0.f, 0.f, 0.f, 0.f};
        bf16x8 vt[2][2];
#pragma unroll
        for (int et = 0; et < 2; ++et)
#pragma unroll
          for (int kk = 0; kk < 2; ++kk) vt[et][kk] = ldfrag(VT, 32 * w + et * 16 + l15, kk * 4 + quad, sx);
#pragma unroll
        for (int kk = 0; kk < 2; ++kk)
#pragma unroll
          for (int i4 = 0; i4 < 4; ++i4) {
            bf16x8 scf = ldfrag(SC, i4 * 16 + l15, kk * 4 + quad, sx);
#pragma unroll
            for (int et = 0; et < 2; ++et) o[et][i4] = MFMA(vt[et][kk], scf, o[et][i4]);
          }
        asm volatile("" ::: "memory");
#pragma unroll
        for (int kk = 0; kk < 2; ++kk) {
          bf16x8 stf[2];
#pragma unroll
          for (int et = 0; et < 2; ++et) stf[et] = ldfrag(ST, 32 * w + et * 16 + l15, kk * 4 + quad, sx);
#pragma unroll
          for (int i4 = 0; i4 < 4; ++i4) {
            bf16x8 qf = ldfrag(Qs, i4 * 16 + l15, kk * 4 + quad, sx);
#pragma unroll
            for (int et = 0; et < 2; ++et) o[et][i4] = MFMA(stf[et], qf, o[et][i4]);
          }
          asm volatile("" ::: "memory");
        }
#pragma unroll
        for (int et = 0; et < 2; ++et)
#pragma unroll
          for (int i4 = 0; i4 < 4; ++i4) {
            int e0 = 32 * w + et * 16 + quad * 4;
            int i = i4 * 16 + l15;
            uint2 ov;
            ov.x = pack2(o[et][i4][0], o[et][i4][1]);
            ov.y = pack2(o[et][i4][2], o[et][i4][3]);
            *reinterpret_cast<uint2*>(obuf + (size_t)(rb + i) * 1024 + hg * 128 + e0) = ov;
          }
        asm volatile("" ::: "memory");
#pragma unroll
        for (int dt = 0; dt < 4; ++dt) {
          f32x4 dc = *reinterpret_cast<const f32x4*>(DEC + dt * 16 + quad * 4);
#pragma unroll
          for (int et = 0; et < 2; ++et) S[dt][et] *= dc;
        }
#pragma unroll
        for (int kk = 0; kk < 2; ++kk)
#pragma unroll
          for (int dt = 0; dt < 4; ++dt) {
            bf16x8 kf = ldfrag(KdT, dt * 16 + l15, kk * 4 + quad, sx);
#pragma unroll
            for (int et = 0; et < 2; ++et) S[dt][et] = MFMA(kf, vt[et][kk], S[dt][et]);
          }
#pragma unroll
        for (int dt = 0; dt < 4; ++dt)
#pragma unroll
          for (int et = 0; et < 2; ++et) {
            int e = 32 * w + et * 16 + l15, d0 = dt * 16 + quad * 4;
            uint2 ov;
            ov.x = pack2(S[dt][et][0], S[dt][et][1]);
            ov.y = pack2(S[dt][et][2], S[dt][et][3]);
            *reinterpret_cast<uint2*>(ST + e * 128 + (((d0 >> 3) ^ sx) << 4) + (d0 & 7) * 2) = ov;
          }
      }
      __syncthreads();
      stage_chunk(Qs, Ks, KdT, VT, LRb, tid, rq0, rq1, rk0, rk1, rv0, rv1, rv2, rv3, rl, !gla, dir, ld);
      {
        if (gla) {
          bf16x8 afr = (bf16x8){0, 0, 0, 0, 0, 0, 0, 0};
          if (quad < 2) afr = *reinterpret_cast<const bf16x8*>(&rl);
#pragma unroll
          for (int dt = 0; dt < 4; ++dt) {
            f32x4 z = MFMA(afr, wafr[dt], ((f32x4){0.f, 0.f, 0.f, 0.f}));
#pragma unroll
            for (int j = 0; j < 4; ++j) {
              float zz = z[j] + bav[dt];
              gv[dt][j] = (fminf(zz, 0.f) - __logf(1.f + __expf(-fabsf(zz)))) * (1.f / 16.f);
            }
          }
#pragma unroll
          for (int dt = 0; dt < 4; ++dt) {
            gv[dt][1] += gv[dt][0];
            gv[dt][2] += gv[dt][1];
            gv[dt][3] += gv[dt][2];
            const float T = gv[dt][3];
            const float x1 = __shfl_up(T, 16, 64), x2 = __shfl_up(T, 32, 64), x3 = __shfl_up(T, 48, 64);
            const float E = (quad >= 1 ? x1 : 0.f) + (quad >= 2 ? x2 : 0.f) + (quad >= 3 ? x3 : 0.f);
            Eq[dt] = E;
            const float Wt = __shfl(E + T, 48 + l15, 64);
            if (quad == 0) TOT[w * 64 + dt * 16 + l15] = Wt;
          }
        } else {
#pragma unroll
          for (int dt = 0; dt < 4; ++dt) {
#pragma unroll
            for (int j = 0; j < 4; ++j) gv[dt][j] = ld * (float)(j + 1);
            Eq[dt] = ld * (float)(4 * quad);
          }
        }
      }
      __syncthreads();
    }
#undef PREFETCH
    if (!sample) {
      int lo_ = quad * 512 + 32 * w + l15;
      asm volatile("" : "+v"(lo_));
      float* dp = p.out + (gla ? OFF_SG : OFF_SR) + (size_t)((b * 2 + dir) * 4 + hh) * 8192 + lo_;
#pragma unroll
      for (int dt = 0; dt < 4; ++dt)
#pragma unroll
        for (int et = 0; et < 2; ++et)
#pragma unroll
          for (int jj = 0; jj < 4; ++jj)
            dp[dt * 2048 + jj * 128 + et * 16] = S[dt][et][jj];
    }
  }
}

__device__ void mix_phase(const P& p, int bid, int nb) {
  const int tid_ = opaque_tid();
  const int lane = tid_ & 63, wid = tid_ >> 6;
  const int col0 = lane * 16, hg = lane >> 3;
  const int nw = nb * 4;
  const int zoff = 1024 + (hg < 4 ? col0 : col0 + 1024);
  float gwv[16];
#pragma unroll
  for (int i = 0; i < 16; ++i) gwv[i] = (hg < 4) ? 1.f : p.gla_nw[(col0 & 127) + i];
  for (int r0 = bid * 4 + wid; r0 < NROWS / 2; r0 += nw) {
    uint4 f0[2], f1[2], b0[2], b1[2], z0[2], z1[2];
#pragma unroll
    for (int u = 0; u < 2; ++u) {
      const int row = r0 + u * (NROWS / 2);
      const uint4* pf = reinterpret_cast<const uint4*>(p.of + (size_t)row * 1024 + col0);
      const uint4* pb = reinterpret_cast<const uint4*>(p.ob + (size_t)row * 1024 + col0);
      const uint4* pz = reinterpret_cast<const uint4*>(p.proj + (size_t)row * NPROJ + zoff);
      f0[u] = pf[0]; f1[u] = pf[1]; b0[u] = pb[0]; b1[u] = pb[1]; z0[u] = pz[0]; z1[u] = pz[1];
    }
#pragma unroll
    for (int u = 0; u < 2; ++u) {
      const int row = r0 + u * (NROWS / 2);
      const u32 fw[8] = {f0[u].x, f0[u].y, f0[u].z, f0[u].w, f1[u].x, f1[u].y, f1[u].z, f1[u].w};
      const u32 bw[8] = {b0[u].x, b0[u].y, b0[u].z, b0[u].w, b1[u].x, b1[u].y, b1[u].z, b1[u].w};
      const u32 zw[8] = {z0[u].x, z0[u].y, z0[u].z, z0[u].w, z1[u].x, z1[u].y, z1[u].z, z1[u].w};
      float o[16];
      float s1 = 0.f;
#pragma unroll
      for (int i = 0; i < 8; ++i) {
        o[2 * i] = bflo(fw[i]) + bflo(bw[i]);
        o[2 * i + 1] = bfhi(fw[i]) + bfhi(bw[i]);
        s1 += o[2 * i] + o[2 * i + 1];
      }
      s1 += __shfl_xor(s1, 1, 64);
      s1 += __shfl_xor(s1, 2, 64);
      s1 += __shfl_xor(s1, 4, 64);
      const float mu = (hg < 4) ? s1 * (1.f / 128.f) : 0.f;
      float s2 = 0.f;
#pragma unroll
      for (int i = 0; i < 16; ++i) { float dlt = o[i] - mu; s2 += dlt * dlt; }
      s2 += __shfl_xor(s2, 1, 64);
      s2 += __shfl_xor(s2, 2, 64);
      s2 += __shfl_xor(s2, 4, 64);
      const float rs = rsqrtf(s2 * (1.f / 128.f) + EPS);
      u32 ow[8];
#pragma unroll
      for (int i = 0; i < 8; ++i) {
        float za = bflo(zw[i]), zb = bfhi(zw[i]);
        float ya = (o[2 * i] - mu) * rs * gwv[2 * i] * (za * __builtin_amdgcn_rcpf(1.f + __expf(-za)));
        float yb = (o[2 * i + 1] - mu) * rs * gwv[2 * i + 1] * (zb * __builtin_amdgcn_rcpf(1.f + __expf(-zb)));
        ow[i] = pack2(ya, yb);
      }
      uint4* po = reinterpret_cast<uint4*>(p.h + (size_t)row * 1024 + col0);
      po[0] = make_uint4(ow[0], ow[1], ow[2], ow[3]);
      po[1] = make_uint4(ow[4], ow[5], ow[6], ow[7]);
    }
  }
}

__device__ void final_phase(const P& p, int bid, int nb) {
  const int tid_ = opaque_tid();
  const int lane = tid_ & 63, wid = tid_ >> 6;
  const int nw = nb * 4;
  float4 fw[4];
#pragma unroll
  for (int i = 0; i < 4; ++i) fw[i] = reinterpret_cast<const float4*>(p.fnw)[lane + 64 * i];
  for (int r0 = bid * 4 + wid; r0 < NROWS / 2; r0 += nw) {
    float4 v[2][4];
#pragma unroll
    for (int u = 0; u < 2; ++u)
#pragma unroll
      for (int i = 0; i < 4; ++i)
        v[u][i] = reinterpret_cast<const float4*>(p.out + (size_t)(r0 + u * (NROWS / 2)) * 1024)[lane + 64 * i];
#pragma unroll
    for (int u = 0; u < 2; ++u) {
      float4* yr = reinterpret_cast<float4*>(p.out + (size_t)(r0 + u * (NROWS / 2)) * 1024);
      float ss = 0.f;
#pragma unroll
      for (int i = 0; i < 4; ++i)
        ss += v[u][i].x * v[u][i].x + v[u][i].y * v[u][i].y + v[u][i].z * v[u][i].z + v[u][i].w * v[u][i].w;
      ss = wave_sum(ss);
      const float r = rsqrtf(ss * (1.f / 1024.f) + EPS);
#pragma unroll
      for (int i = 0; i < 4; ++i)
        yr[lane + 64 * i] = make_float4(v[u][i].x * r * fw[i].x, v[u][i].y * r * fw[i].y, v[u][i].z * r * fw[i].z,
                                        v[u][i].w * r * fw[i].w);
    }
  }
}

template <int PH>
__device__ __forceinline__ void run_phase(const P& p, int bid, int nb, char* smem) {
  if (PH == 0) phase0(p, bid, nb, smem);
  if (PH == 1) phase1(p, bid, nb);
  if (PH == 2) gemm_phase<1>(p, bid & 7, bid >> 3, nb >> 3, smem, 0);
  if (PH == 3) rec_phase(p, smem, bid, nullptr);
  if (PH == 4) mix_phase(p, bid, nb);
  if (PH == 5) gemm_phase<2>(p, bid & 7, bid >> 3, nb >> 3, smem, 2);
  if (PH == 6) final_phase(p, bid, nb);
}

#if MULTI_LAUNCH
template <int PH>
__global__ void __launch_bounds__(256, 2) phase_kernel(P p) {
  extern __shared__ __attribute__((aligned(16))) char smem[];
  run_phase<PH>(p, blockIdx.x, gridDim.x, smem);
}
#else
__global__ void __launch_bounds__(256, 2) mega_kernel(P p) {
  extern __shared__ __attribute__((aligned(16))) char smem[];
  __shared__ uint4 xb_words;
  if (threadIdx.x == 0) xb_words = make_uint4(0u, 0u, 0u, 0u);
  __syncthreads();
  XcdBarrier xb = xcd_barrier_post(p.bar, (volatile LAS unsigned*)&xb_words);
  const int bid = blockIdx.x, nb = gridDim.x;
  run_phase<0>(p, bid, nb, smem);
  xcd_barrier(xb);
  run_phase<1>(p, bid, nb, smem);
  xcd_barrier(xb);
  {
    const bool heavy = rec_is_heavy(bid);
    const int g_ = bid & 7, l_ = bid >> 3;
    const bool hgla = (l_ >> 1) >= 4;
    unsigned* gq = p.bar + 3520 + g_ * 64;
    int* sWork = reinterpret_cast<int*>(smem + 71168);
    bool scanned = !heavy;
#pragma nounroll
    for (;;) {
      int kind = 0, tm = 4, mtx = 0, ntx = 0, item = 0, post = 0;
      unsigned* gate = nullptr;
      unsigned gtarget = 0u;
      __syncthreads();
      if (threadIdx.x == 0) {
        int go = 0;
        if (!scanned) go = (xb_ld(gq + 16) >= (hgla ? 144u : 272u)) ? 1 : 0;
        sWork[1] = go;
        sWork[0] = go ? 0 : (int)xb_add(gq + 16, 1u);
      }
      __syncthreads();
      const int go_ = __builtin_amdgcn_readfirstlane(sWork[1]);
      const int wk = __builtin_amdgcn_readfirstlane(sWork[0]);
      if (go_) {
        kind = 1; item = (g_ << 4) | l_; scanned = true;
        gate = hgla ? (gq + 32) : (gq + 36); gtarget = hgla ? 144u : 128u;
      } else if (wk >= 664) {
        if (scanned) break;
        continue;
      } else if (wk < 144) { const int j_ = wk >> 4; ntx = (j_ < 8) ? 12 + j_ : 24; mtx = 64 + 16 * g_ + (wk & 15); tm = 3; post = 32; }
      else if (wk < 272) { const int u_ = wk - 144; ntx = u_ >> 4; mtx = 64 + 16 * g_ + (u_ & 15); tm = 3; post = 36; }
      else if (wk < 408) { const int u_ = wk - 272, j_ = u_ >> 3; ntx = (j_ < 8) ? j_ : (j_ < 16 ? j_ + 4 : 24); mtx = 8 * g_ + (u_ & 7); tm = 3; post = 40; }
      else if (wk >= 456 && wk < 520) { kind = 1; const int r_ = wk - 456; item = 128 + (((4 * g_ + (r_ >> 4)) << 4) | (r_ & 15)); gate = gq + 40; gtarget = 136u; }
      else {
        const int v_ = (wk < 456) ? wk - 408 : wk - 520 + 48;
        if (v_ < 64) { const int j_ = v_ >> 3; ntx = (j_ < 4) ? 8 + j_ : 16 + j_; mtx = 8 * g_ + (v_ & 7); }
        else { const int u_ = v_ - 64, j_ = u_ >> 4; ntx = (j_ < 4) ? 8 + j_ : 16 + j_; mtx = 64 + 16 * g_ + (u_ & 15); }
      }
      if (kind == 0) gemm_phase<1>(p, g_, 0, 1, smem, tm, mtx, ntx);
      else rec_phase(p, smem, item, gate, gtarget);
      if (post) {
        asm volatile("s_waitcnt vmcnt(0)" ::: "memory");
        __syncthreads();
        if (threadIdx.x == 0) xb_add(gq + post, 1u);
      }
    }
  }
  xcd_barrier(xb);
  run_phase<4>(p, bid, nb, smem);
  xcd_barrier(xb);
  run_phase<5>(p, bid, nb, smem);
}
#endif

extern "C" void kernel_launch(void* const* d_in, const int* in_sizes, int n_in, void* d_out, int out_size,
                              void* d_ws, size_t ws_size, hipStream_t stream) {
  constexpr size_t WS_MOD = 0, WS_ROPE = 131072, WS_WTIN = 262144, WS_WTOUT = WS_WTIN + 6553600,
                   WS_H = WS_WTOUT + 2097152, WS_PROJ = WS_H + 50331648, WS_END = WS_PROJ + (size_t)NROWS * NPROJ * 2;
  if (ws_size < WS_END + 32768 || n_in != 15) { fprintf(stderr, "kernel_launch: bad ws/n_in\n"); return; }
  P p{};
  p.x_prompt = (const float*)d_in[0]; p.x_sample = (const float*)d_in[1]; p.c = (const float*)d_in[2];
  p.state_ret = (const float*)d_in[3]; p.state_gla = (const float*)d_in[4]; p.c_ctx = (const float*)d_in[5];
  p.w_mod = (const float*)d_in[6]; p.b_mod = (const float*)d_in[7]; p.w_in = (const float*)d_in[8];
  p.ret_ld = (const float*)d_in[9]; p.gla_wa = (const float*)d_in[10]; p.gla_ba = (const float*)d_in[11];
  p.gla_nw = (const float*)d_in[12]; p.w_out = (const float*)d_in[13]; p.fnw = (const float*)d_in[14];
  p.out = (float*)d_out;
  char* ws = (char*)d_ws;
  p.mod = (float*)(ws + WS_MOD); p.rope = (float*)(ws + WS_ROPE); p.bar = (unsigned*)(ws + 114688); p.rowss = (float*)(ws + 147456); p.mcnt = (unsigned*)(ws + 245760);
  p.wt_in = (u16*)(ws + WS_WTIN); p.wt_out = (u16*)(ws + WS_WTOUT);
  p.h = (u16*)(ws + WS_H); p.proj = (u16*)(ws + WS_PROJ); p.watab = (uint4*)(ws + WS_END);
  p.of = (u16*)d_out; p.ob = (u16*)d_out + (size_t)NROWS * 1024;
  (void)hipMemsetAsync(ws, 0, 262144, stream);
#if MULTI_LAUNCH
  static int inited = 0;
  if (!inited) {
    hipFuncSetAttribute((const void*)phase_kernel<0>, hipFuncAttributeMaxDynamicSharedMemorySize, LDS_BYTES);
    hipFuncSetAttribute((const void*)phase_kernel<1>, hipFuncAttributeMaxDynamicSharedMemorySize, LDS_BYTES);
    hipFuncSetAttribute((const void*)phase_kernel<2>, hipFuncAttributeMaxDynamicSharedMemorySize, LDS_BYTES);
    hipFuncSetAttribute((const void*)phase_kernel<3>, hipFuncAttributeMaxDynamicSharedMemorySize, LDS_BYTES);
    hipFuncSetAttribute((const void*)phase_kernel<4>, hipFuncAttributeMaxDynamicSharedMemorySize, LDS_BYTES);
    hipFuncSetAttribute((const void*)phase_kernel<5>, hipFuncAttributeMaxDynamicSharedMemorySize, LDS_BYTES);
    hipFuncSetAttribute((const void*)phase_kernel<6>, hipFuncAttributeMaxDynamicSharedMemorySize, LDS_BYTES);
    inited = 1;
  }
  const int G = 512;
  phase_kernel<0><<<G, 256, LDS_BYTES, stream>>>(p);
  phase_kernel<1><<<G, 256, LDS_BYTES, stream>>>(p);
  phase_kernel<2><<<G, 256, LDS_BYTES, stream>>>(p);
  phase_kernel<3><<<G, 256, LDS_BYTES, stream>>>(p);
  phase_kernel<4><<<G, 256, LDS_BYTES, stream>>>(p);
  phase_kernel<5><<<G, 256, LDS_BYTES, stream>>>(p);
  phase_kernel<6><<<G, 256, LDS_BYTES, stream>>>(p);
#else
  static int grid_blocks = 0;
  if (!grid_blocks) {
    int dev = 0, cus = 0, per_cu = 0;
    hipGetDevice(&dev);
    hipDeviceGetAttribute(&cus, hipDeviceAttributeMultiprocessorCount, dev);
    hipFuncSetAttribute((const void*)mega_kernel, hipFuncAttributeMaxDynamicSharedMemorySize, LDS_BYTES);
    hipOccupancyMaxActiveBlocksPerMultiprocessor(&per_cu, (const void*)mega_kernel, 256, LDS_BYTES);
    (void)per_cu;
    per_cu = 2;
    grid_blocks = cus * per_cu;
  }
  void* args[] = {&p};
  hipError_t e = hipLaunchCooperativeKernel((const void*)mega_kernel, dim3(grid_blocks), dim3(256), args, LDS_BYTES, stream);
  if (e != hipSuccess) fprintf(stderr, "cooperative launch failed: %s (grid %d)\n", hipGetErrorString(e), grid_blocks);
#endif
}
```

```cpp
#include <hip/hip_runtime.h>
#include <cstdio>

#ifndef MULTI_LAUNCH
#define MULTI_LAUNCH 0
#endif

typedef unsigned short u16;
typedef unsigned int u32;
using bf16x8 = __attribute__((ext_vector_type(8))) short;
using f32x4 = __attribute__((ext_vector_type(4))) float;

constexpr int NROWS = 24576;
constexpr int NCTX = 8192;
constexpr int NPROJ = 3104;
constexpr int LDS_BYTES = 73728;
constexpr size_t OFF_SR = (size_t)NROWS * 1024;
constexpr size_t OFF_SG = OFF_SR + 2097152;
constexpr float EPS = 1e-6f;

struct P {
  const float *x_prompt, *x_sample, *c, *state_ret, *state_gla, *c_ctx, *w_mod, *b_mod, *w_in, *ret_ld,
      *gla_wa, *gla_ba, *gla_nw, *w_out, *fnw;
  float* out;
  float* mod;
  float* rope;
  u16* wt_in;
  u16* wt_out;
  u16* h;
  u16* proj;
  u16* of;
  u16* ob;
  unsigned* bar;
  uint4* watab;
  float* rowss;
  unsigned* mcnt;
};

__device__ __forceinline__ u32 f2bf(float f) {
  u32 u = __float_as_uint(f);
  return (u + 0x7fffu + ((u >> 16) & 1u)) >> 16;
}
typedef __bf16 bf16x2_t __attribute__((ext_vector_type(2)));
typedef float f32x2_t __attribute__((ext_vector_type(2)));
__device__ __forceinline__ u32 pack2(float a, float b) {
  f32x2_t v = {a, b};
  bf16x2_t r = __builtin_convertvector(v, bf16x2_t);
  return *reinterpret_cast<u32*>(&r);
}
__device__ __forceinline__ float bflo(u32 w) { return __uint_as_float(w << 16); }
__device__ __forceinline__ float bfhi(u32 w) { return __uint_as_float(w & 0xffff0000u); }
__device__ __forceinline__ float wave_sum(float v) {
#pragma unroll
  for (int m = 32; m >= 1; m >>= 1) v += __shfl_xor(v, m, 64);
  return v;
}
__device__ __forceinline__ bf16x8 ldfrag(const char* base, int row, int c16, int sx) {
  return *reinterpret_cast<const bf16x8*>(base + row * 128 + ((c16 ^ sx) << 4));
}
__device__ __forceinline__ int opaque_tid() { int t = threadIdx.x; asm volatile("" : "+v"(t)); return t; }
#define MFMA(a, b, c) __builtin_amdgcn_mfma_f32_16x16x32_bf16(a, b, c, 0, 0, 0)

#define XB_TMO      128
#define XB_XCNT(j)  (256  + 64 * (j))
#define XB_XSUB(j)  (1280 + 64 * (j))
#define XB_XGEN(j)  (2304 + 64 * (j))
#define XB_TOP      3328
#define XB_TOPGEN   3392
#define XCD_BAR_WORDS 3456
#define XB_SPIN_CAP (1u << 18)
#define LAS __attribute__((address_space(3)))
__device__ __forceinline__ unsigned xb_ld(unsigned* p) { return __hip_atomic_load(p, __ATOMIC_RELAXED, __HIP_MEMORY_SCOPE_AGENT); }
__device__ __forceinline__ unsigned xb_add(unsigned* p, unsigned v) { return __hip_atomic_fetch_add(p, v, __ATOMIC_RELAXED, __HIP_MEMORY_SCOPE_AGENT); }
__device__ __forceinline__ unsigned xb_xcc_id() { return (unsigned)__builtin_amdgcn_s_getreg((3 << 11) | 20) & 0xFu; }
#define XB_SPIN(cond, bar) do { unsigned _sp = 0; while (cond) { __builtin_amdgcn_s_sleep(1); \
    if ((++_sp & 255u) == 0u) { if (xb_ld(&(bar)[XB_TMO])) break; if (_sp > XB_SPIN_CAP) { atomicAdd(&(bar)[XB_TMO], 1u); break; } } } } while (0)
struct XcdBarrier { unsigned* bar; unsigned x; volatile LAS unsigned* st; };
__device__ __forceinline__ XcdBarrier xcd_barrier_post(unsigned* bar, volatile LAS unsigned* st) {
  XcdBarrier b; b.bar = bar; b.x = xb_xcc_id(); b.st = st;
  if (threadIdx.x == 0) (void)xb_add(&bar[XB_XCNT(b.x)], 1u);
  return b;
}
__device__ __forceinline__ void xcd_barrier_complete(unsigned* bar, unsigned x, unsigned& nloc, unsigned& nx) {
  const unsigned G = gridDim.x * gridDim.y * gridDim.z;
  unsigned sum, cnt, mine, sp = 0u;
  for (;;) {
    sum = 0u; cnt = 0u; mine = 0u;
#pragma unroll
    for (unsigned j = 0; j < 16; ++j) { const unsigned c = xb_ld(&bar[XB_XCNT(j)]); sum += c; cnt += (c > 0u) ? 1u : 0u; mine = (j == x) ? c : mine; }
    if (sum == G) break;
    __builtin_amdgcn_s_sleep(1);
    if ((++sp & 255u) == 0u) { if (xb_ld(&bar[XB_TMO])) break; if (sp > XB_SPIN_CAP) { atomicAdd(&bar[XB_TMO], 1u); break; } }
  }
  nloc = mine > 0u ? mine : 1u; nx = cnt > 0u ? cnt : 1u;
}
__device__ __forceinline__ void xcd_barrier(const XcdBarrier& b) {
  asm volatile("s_waitcnt vmcnt(0)" ::: "memory");
  __syncthreads();
  if (threadIdx.x == 0) {
    unsigned* bar = b.bar;
    __builtin_amdgcn_s_waitcnt(0);
    const unsigned bx = xb_xcc_id();
    unsigned nloc = b.st[0], nx = b.st[1];
    if (nloc == 0u) { xcd_barrier_complete(bar, bx, nloc, nx); b.st[0] = nloc; b.st[1] = nx; }
    const unsigned old = xb_add(&bar[XB_XSUB(bx)], 1u);
    const unsigned gen = old / nloc;
    if (old + 1u == (gen + 1u) * nloc) {
      __builtin_amdgcn_fence(__ATOMIC_RELEASE, "agent");
      asm volatile("s_waitcnt vmcnt(0)" ::: "memory");
      const unsigned og = xb_add(&bar[XB_TOP], 1u);
      const unsigned tg = og / nx;
      if (og + 1u == (tg + 1u) * nx) xb_add(&bar[XB_TOPGEN], 1u);
      else XB_SPIN(xb_ld(&bar[XB_TOPGEN]) == tg, bar);
      __builtin_amdgcn_fence(__ATOMIC_ACQUIRE, "agent");
      xb_add(&bar[XB_XGEN(bx)], 1u);
      asm volatile("s_waitcnt vmcnt(0)" ::: "memory");
    } else {
      XB_SPIN(xb_ld(&bar[XB_XGEN(bx)]) == gen, bar);
      __builtin_amdgcn_fence(__ATOMIC_ACQUIRE, "agent");
      asm volatile("s_waitcnt vmcnt(0)" ::: "memory");
    }
  }
  __syncthreads();
}

__device__ __forceinline__ void group_barrier(unsigned* ctr, unsigned n) {
  asm volatile("s_waitcnt vmcnt(0)" ::: "memory");
  __syncthreads();
  if (threadIdx.x == 0) {
    __builtin_amdgcn_fence(__ATOMIC_RELEASE, "agent");
    asm volatile("s_waitcnt vmcnt(0)" ::: "memory");
    xb_add(ctr, 1u);
    unsigned sp = 0;
    while (xb_ld(ctr) < n) { __builtin_amdgcn_s_sleep(8); if (++sp > (1u << 20)) break; }
    __builtin_amdgcn_fence(__ATOMIC_ACQUIRE, "agent");
    asm volatile("s_waitcnt vmcnt(0)" ::: "memory");
  }
  __syncthreads();
}

__device__ __forceinline__ void transpose_tile(const float* __restrict__ src, u16* __restrict__ dst, const int N,
                                               const int kt, const int ntile, char* smem, const int lane, const int wid) {
  float* tile = (float*)smem;
  const int k0 = kt * 64, n0 = ntile * 64;
  float tv_[16];
#pragma unroll
  for (int i = 0; i < 16; ++i) {
    int n = n0 + lane;
    tv_[i] = (n < N) ? src[(size_t)(k0 + wid + 4 * i) * N + n] : 0.f;
  }
#pragma unroll
  for (int i = 0; i < 16; ++i) tile[(wid + 4 * i) * 65 + lane] = tv_[i];
  __syncthreads();
  for (int i = wid; i < 64; i += 4)
    dst[(size_t)(n0 + i) * 1024 + k0 + lane] = (u16)f2bf(tile[lane * 65 + i]);
  __syncthreads();
}

__device__ void phase0(const P& p, int bid, int nb, char* smem) {
  const int tid = opaque_tid(), lane = tid & 63, wid = tid >> 6;
  const int NIT = 384 + 800 + 256 + 2;
  for (int it = bid; it < NIT; it += nb) {
    if (it < 384) {
      const int cb = it % 48, kc = it / 48;
      float* s = (float*)smem;
      float* red = s + 9 * 128;
      for (int i = tid; i < 9 * 128; i += 256) {
        int ci = i >> 7, kk = i & 127;
        int k = kc * 128 + kk;
        float v = (ci == 0) ? p.c_ctx[k] : p.c[(ci - 1) * 1024 + k];
        s[i] = v / (1.f + __expf(-v));
      }
      __syncthreads();
      float acc[9];
#pragma unroll
      for (int ci = 0; ci < 9; ++ci) acc[ci] = 0.f;
      const int col = cb * 64 + lane;
      const float* wp = p.w_mod + (size_t)(kc * 128 + wid * 32) * 3072 + col;
      float wv_[32];
#pragma unroll
      for (int kk = 0; kk < 32; ++kk) wv_[kk] = wp[(size_t)kk * 3072];
#pragma unroll
      for (int kk = 0; kk < 32; ++kk) {
        float w = wv_[kk];
#pragma unroll
        for (int ci = 0; ci < 9; ++ci) acc[ci] += s[ci * 128 + wid * 32 + kk] * w;
      }
#pragma unroll
      for (int ci = 0; ci < 9; ++ci) red[(wid * 9 + ci) * 64 + lane] = acc[ci];
      __syncthreads();
      for (int i = tid; i < 9 * 64; i += 256) {
        int ci = i >> 6, l = i & 63;
        float v = red[(0 * 9 + ci) * 64 + l] + red[(1 * 9 + ci) * 64 + l] + red[(2 * 9 + ci) * 64 + l] +
                  red[(3 * 9 + ci) * 64 + l];
        if (kc == 0) v += p.b_mod[cb * 64 + l];
        atomicAdd(&p.mod[ci * 3072 + cb * 64 + l], v);
      }
      __syncthreads();
    } else if (it < 384 + 800) {
      const int j = it - 384;
      transpose_tile(p.w_in, p.wt_in, NPROJ, j / 50, j % 50, smem, lane, wid);
    } else if (it < 384 + 800 + 256) {
      const int j = it - 384 - 800;
      transpose_tile(p.w_out, p.wt_out, 1024, j >> 4, j & 15, smem, lane, wid);
    } else if (it == 384 + 800 + 256 + 1) {
      for (int i = tid; i < 2048; i += 256) {
        const int ln = i & 63, dt = (i >> 6) & 3, hh = (i >> 8) & 3, dir = i >> 10;
        const int l15_ = ln & 15, quad_ = ln >> 4;
        uint4 wv = make_uint4(0u, 0u, 0u, 0u);
        if (quad_ < 2) {
          const float* wp_ = p.gla_wa + (size_t)(dir * 16 + quad_ * 8) * 256 + hh * 64 + dt * 16 + l15_;
          wv = make_uint4(pack2(wp_[0], wp_[256]), pack2(wp_[512], wp_[768]), pack2(wp_[1024], wp_[1280]), pack2(wp_[1536], wp_[1792]));
        }
        p.watab[i] = wv;
      }
    } else {
      for (int i = tid; i < 1024; i += 256) {
        int pos = i >> 4, f = i & 15;
        float inv = powf(10000.f, -(float)f / 16.f);
        float ang = (float)pos * inv;
        p.rope[i] = cosf(ang);
        p.rope[1024 + i] = sinf(ang);
      }
    }
  }
}

__device__ void phase1(const P& p, int bid, int nb) {
  const int tid_ = opaque_tid();
  const int lane = tid_ & 63, wid = tid_ >> 6;
  const int nw = nb * 4;
  for (int r0 = bid * 4 + wid; r0 < NROWS / 2; r0 += nw) {
    const float* xr[2];
    int ci[2];
#pragma unroll
    for (int u = 0; u < 2; ++u) {
      const int row = r0 + u * (NROWS / 2);
      if (row < NCTX) { xr[u] = p.x_prompt + (size_t)row * 1024; ci[u] = 0; }
      else { xr[u] = p.x_sample + (size_t)(row - NCTX) * 1024; ci[u] = 1 + ((row - NCTX) >> 11); }
    }
    float4 v[2][4];
#pragma unroll
    for (int u = 0; u < 2; ++u)
#pragma unroll
      for (int i = 0; i < 4; ++i) v[u][i] = reinterpret_cast<const float4*>(xr[u])[lane + 64 * i];
#pragma unroll
    for (int u = 0; u < 2; ++u) {
      const int row = r0 + u * (NROWS / 2);
      float ss = 0.f;
#pragma unroll
      for (int i = 0; i < 4; ++i)
        ss += v[u][i].x * v[u][i].x + v[u][i].y * v[u][i].y + v[u][i].z * v[u][i].z + v[u][i].w * v[u][i].w;
      ss = wave_sum(ss);
      const float r = rsqrtf(ss * (1.f / 1024.f) + EPS);
      const float* md = p.mod + ci[u] * 3072;
#pragma unroll
      for (int i = 0; i < 4; ++i) {
        int col = (lane + 64 * i) * 4;
        float4 sh = *reinterpret_cast<const float4*>(md + col);
        float4 sc = *reinterpret_cast<const float4*>(md + 1024 + col);
        uint2 o;
        o.x = pack2(v[u][i].x * r * (1.f + sc.x) + sh.x, v[u][i].y * r * (1.f + sc.y) + sh.y);
        o.y = pack2(v[u][i].z * r * (1.f + sc.z) + sh.z, v[u][i].w * r * (1.f + sc.w) + sh.w);
        *reinterpret_cast<uint2*>(p.h + (size_t)row * 1024 + col) = o;
      }
    }
  }
}

template <int MODE>
__device__ void gemm_phase(const P& p, const int xcd, const int local, const int nlocal, char* smem, const int tmode,
                           const int mt_x = 0, const int nt_x = 0) {
  constexpr int NT = (MODE == 1) ? 25 : 8;
  const u16* A = p.h;
  const u16* B = (MODE == 1) ? p.wt_in : p.wt_out;
  const int tid = opaque_tid(), lane = tid & 63, wid = tid >> 6, wr = wid >> 1, wc = wid & 1;
  const int l15 = lane & 15, quad = lane >> 4, sx = (l15 >> 1) & 7;
  const int lrow = tid >> 3, lc16 = tid & 7;
  const int wofs = lrow * 128 + ((lc16 ^ ((lrow >> 1) & 7)) << 4);
  const int ntiles = (tmode == 0) ? 320 : (tmode == 1 ? 280 : (tmode == 2 ? 192 : local + 1));
  for (int t = local; t < ntiles; t += nlocal) {
    int nt, mt;
    if (tmode == 0) {
      const int mg = t / 160, r_ = t % 160, j_ = r_ >> 3;
      nt = (j_ < 8) ? j_ : (j_ < 16 ? j_ + 4 : j_ + 5);
      mt = 64 + xcd * 16 + mg * 8 + (r_ & 7);
    } else if (tmode == 1) {
      if (t < 200) { nt = t >> 3; mt = xcd * 8 + (t & 7); }
      else { const int u_ = t - 200, mg = u_ / 40, r_ = u_ % 40, j_ = r_ >> 3; nt = (j_ < 4) ? 8 + j_ : 20; mt = 64 + xcd * 16 + mg * 8 + (r_ & 7); }
    } else if (tmode == 2) {
      const int mg = t >> 6, r_ = t & 63;
      nt = r_ >> 3; mt = xcd * 24 + mg * 8 + (r_ & 7);
    } else {
      nt = nt_x; mt = mt_x;
    }
    const int m0 = mt * 128, n0 = nt * 128;
    f32x4 acc[4][4];
#pragma unroll
    for (int a = 0; a < 4; ++a)
#pragma unroll
      for (int b = 0; b < 4; ++b) acc[a][b] = (f32x4){0.f, 0.f, 0.f, 0.f};
    const u16* ag = A + (size_t)(m0 + lrow) * 1024 + lc16 * 8;
    const u16* bg = B + (size_t)(n0 + lrow) * 1024 + lc16 * 8;
    uint4 ra0, ra1, ra2, ra3, rb0, rb1, rb2, rb3;
    uint4 sa0, sa1, sa2, sa3, sb0, sb1, sb2, sb3;
#define GLOAD(R, S, ksv)                                                              \
  {                                                                                   \
    const u16* a_ = ag + (ksv) * 64;                                                  \
    const u16* b_ = bg + (ksv) * 64;                                                  \
    R##0 = *reinterpret_cast<const uint4*>(a_);                                       \
    R##1 = *reinterpret_cast<const uint4*>(a_ + 32 * 1024);                           \
    R##2 = *reinterpret_cast<const uint4*>(a_ + 64 * 1024);                           \
    R##3 = *reinterpret_cast<const uint4*>(a_ + 96 * 1024);                           \
    S##0 = *reinterpret_cast<const uint4*>(b_);                                       \
    S##1 = *reinterpret_cast<const uint4*>(b_ + 32 * 1024);                           \
    S##2 = *reinterpret_cast<const uint4*>(b_ + 64 * 1024);                           \
    S##3 = *reinterpret_cast<const uint4*>(b_ + 96 * 1024);                           \
  }
#define LWRITE(buf, R, S)                                                             \
  {                                                                                   \
    char* d_ = smem + (buf) * 32768 + wofs;                                           \
    *reinterpret_cast<uint4*>(d_) = R##0;                                             \
    *reinterpret_cast<uint4*>(d_ + 4096) = R##1;                                      \
    *reinterpret_cast<uint4*>(d_ + 8192) = R##2;                                      \
    *reinterpret_cast<uint4*>(d_ + 12288) = R##3;                                     \
    *reinterpret_cast<uint4*>(d_ + 16384) = S##0;                                     \
    *reinterpret_cast<uint4*>(d_ + 16384 + 4096) = S##1;                              \
    *reinterpret_cast<uint4*>(d_ + 16384 + 8192) = S##2;                              \
    *reinterpret_cast<uint4*>(d_ + 16384 + 12288) = S##3;                             \
  }
#define COMPUTE(buf)                                                                  \
  {                                                                                   \
    const char* cur = smem + (buf) * 32768;                                           \
    _Pragma("unroll") for (int kk = 0; kk < 2; ++kk) {                                \
      bf16x8 af[4], bfr[4];                                                           \
      _Pragma("unroll") for (int ns = 0; ns < 4; ++ns)                                \
          af[ns] = ldfrag(cur + 16384, wc * 64 + ns * 16 + l15, kk * 4 + quad, sx);   \
      _Pragma("unroll") for (int ms = 0; ms < 4; ++ms)                                \
          bfr[ms] = ldfrag(cur, wr * 64 + ms * 16 + l15, kk * 4 + quad, sx);          \
      _Pragma("unroll") for (int ns = 0; ns < 4; ++ns)                                \
          _Pragma("unroll") for (int ms = 0; ms < 4; ++ms)                            \
              acc[ns][ms] = MFMA(af[ns], bfr[ms], acc[ns][ms]);                       \
    }                                                                                 \
  }
    f32x4 xpre[4][4];
    GLOAD(ra, rb, 0);
    GLOAD(sa, sb, 1);
    LWRITE(0, ra, rb);
    __syncthreads();
#pragma unroll
    for (int ks = 0; ks < 16; ks += 2) {
      if (ks + 2 < 16) GLOAD(ra, rb, ks + 2);
      if (MODE == 2 && ks == 14) {
        const float* xb_ = (m0 < NCTX) ? p.x_prompt : (p.x_sample - (size_t)NCTX * 1024);
        const float* xp_ = xb_ + (size_t)(m0 + wr * 64 + l15) * 1024 + (n0 + wc * 64 + quad * 4);
#pragma unroll
        for (int ns = 0; ns < 4; ++ns)
#pragma unroll
          for (int ms = 0; ms < 4; ++ms) xpre[ns][ms] = *reinterpret_cast<const f32x4*>(xp_ + (size_t)ms * 16 * 1024 + ns * 16);
      }
      __builtin_amdgcn_sched_barrier(0);
      COMPUTE(0);
      LWRITE(1, sa, sb);
      __syncthreads();
      if (ks + 3 < 16) GLOAD(sa, sb, ks + 3);
      __builtin_amdgcn_sched_barrier(0);
      COMPUTE(1);
      if (ks + 2 < 16) LWRITE(0, ra, rb);
      __syncthreads();
    }
#undef GLOAD
#undef LWRITE
#undef COMPUTE
    const int colbase = n0 + wc * 64;
    if (MODE == 1) {
      if (colbase < NPROJ) {
        const bool sample = m0 >= NCTX;
        const bool scaled = (colbase >= 256 && colbase < 512) || (colbase >= 1536 && colbase < 1792);
        if (scaled) {
#pragma unroll
          for (int a = 0; a < 4; ++a)
#pragma unroll
            for (int b = 0; b < 4; ++b) acc[a][b] *= 0.125f;
        }
        if (sample && colbase < 512) {
#pragma unroll
          for (int ms = 0; ms < 4; ++ms) {
            int m = m0 + wr * 64 + ms * 16 + l15;
            int tkn = (m - NCTX) & 2047;
            int r = tkn >> 6, c = tkn & 63;
            f32x4 c0 = *reinterpret_cast<const f32x4*>(p.rope + r * 16 + quad * 4);
            f32x4 s0 = *reinterpret_cast<const f32x4*>(p.rope + 1024 + r * 16 + quad * 4);
            f32x4 c1 = *reinterpret_cast<const f32x4*>(p.rope + c * 16 + quad * 4);
            f32x4 s1 = *reinterpret_cast<const f32x4*>(p.rope + 1024 + c * 16 + quad * 4);
            f32x4 x1 = acc[0][ms], x2 = acc[2][ms];
            acc[0][ms] = x1 * c0 - x2 * s0;
            acc[2][ms] = x2 * c0 + x1 * s0;
            x1 = acc[1][ms]; x2 = acc[3][ms];
            acc[1][ms] = x1 * c1 - x2 * s1;
            acc[3][ms] = x2 * c1 + x1 * s1;
          }
        }
#pragma unroll
        for (int ns = 0; ns < 4; ++ns) {
          int n = colbase + ns * 16 + quad * 4;
          if (n < NPROJ) {
#pragma unroll
            for (int ms = 0; ms < 4; ++ms) {
              int m = m0 + wr * 64 + ms * 16 + l15;
              uint2 o;
              o.x = pack2(acc[ns][ms][0], acc[ns][ms][1]);
              o.y = pack2(acc[ns][ms][2], acc[ns][ms][3]);
              if (tmode == 3)
                __hip_atomic_store(reinterpret_cast<unsigned long long*>(p.proj + (size_t)m * NPROJ + n),
                                   ((unsigned long long)o.y << 32) | o.x, __ATOMIC_RELAXED, __HIP_MEMORY_SCOPE_AGENT);
              else
                *reinterpret_cast<uint2*>(p.proj + (size_t)m * NPROJ + n) = o;
            }
          }
        }
      }
    } else {
      const int ci = (m0 < NCTX) ? 0 : 1 + ((m0 - NCTX) >> 11);
      const float* gate = p.mod + ci * 3072 + 2048;
#pragma unroll
      for (int ns = 0; ns < 4; ++ns) {
        int n = colbase + ns * 16 + quad * 4;
        f32x4 g = *reinterpret_cast<const f32x4*>(gate + n);
#pragma unroll
        for (int ms = 0; ms < 4; ++ms) {
          acc[ns][ms] = xpre[ns][ms] + g * acc[ns][ms];
        }
      }
#pragma unroll
      for (int ms = 0; ms < 4; ++ms) {
        float ssq = 0.f;
#pragma unroll
        for (int ns = 0; ns < 4; ++ns)
#pragma unroll
          for (int j = 0; j < 4; ++j) ssq += acc[ns][ms][j] * acc[ns][ms][j];
        ssq += __shfl_xor(ssq, 16, 64);
        ssq += __shfl_xor(ssq, 32, 64);
        if (quad == 0)
          (void)__hip_atomic_fetch_add(p.rowss + m0 + wr * 64 + ms * 16 + l15, ssq, __ATOMIC_RELAXED, __HIP_MEMORY_SCOPE_AGENT);
      }
      asm volatile("s_waitcnt vmcnt(0)" ::: "memory");
      __syncthreads();
      if (tid == 0) {
        xb_add(p.mcnt + mt, 1u);
        unsigned sp = 0;
        while (xb_ld(p.mcnt + mt) < 8u) { __builtin_amdgcn_s_sleep(2); if (++sp > (1u << 22)) break; }
      }
      __syncthreads();
#pragma unroll
      for (int ms = 0; ms < 4; ++ms) {
        const int m = m0 + wr * 64 + ms * 16 + l15;
        const float ssr = __hip_atomic_load(p.rowss + m, __ATOMIC_RELAXED, __HIP_MEMORY_SCOPE_AGENT);
        const float rn = rsqrtf(ssr * (1.f / 1024.f) + EPS);
#pragma unroll
        for (int ns = 0; ns < 4; ++ns) {
          const int n = colbase + ns * 16 + quad * 4;
          const f32x4 fwv = *reinterpret_cast<const f32x4*>(p.fnw + n);
          *reinterpret_cast<f32x4*>(p.out + (size_t)m * 1024 + n) = acc[ns][ms] * rn * fwv;
        }
      }
    }
  }
}

__device__ __forceinline__ void stage_v(char* VT, const int tid, const uint4 RA, const uint4 RB, const int e8) {
  const int pp = tid & 31;
  const u32 a0[4] = {RA.x, RA.y, RA.z, RA.w};
  const u32 a1[4] = {RB.x, RB.y, RB.z, RB.w};
#pragma unroll
  for (int ei = 0; ei < 8; ++ei) {
    int e = e8 * 8 + ei;
    const u32 pk = __builtin_amdgcn_perm(a1[ei >> 1], a0[ei >> 1], (ei & 1) ? 0x07060302u : 0x05040100u);
    int ofs = e * 128 + (((pp >> 2) ^ ((e >> 1) & 7)) << 4) + (pp & 3) * 4;
    *reinterpret_cast<u32*>(VT + ofs) = pk;
  }
}
__device__ __forceinline__ void stage_ret_row(char* Qs, char* Ks, char* KdT, const int ofs, const int t, const int c16,
                                              const uint4 rq, const uint4 rk, const float b, const float kdsc) {
  const float eb = __expf(b);
  const float ei = __builtin_amdgcn_rcpf(eb);
  const float kd = ei * kdsc;
  const u32 qw[4] = {rq.x, rq.y, rq.z, rq.w};
  const u32 kw[4] = {rk.x, rk.y, rk.z, rk.w};
  u32 qo[4], ko[4];
  char* kcol = KdT + (c16 * 8) * 128 + (t & 7) * 2;
  const int tch = t >> 3;
#pragma unroll
  for (int i = 0; i < 4; ++i) {
    const float q0 = bflo(qw[i]), q1 = bfhi(qw[i]), k0 = bflo(kw[i]), k1 = bfhi(kw[i]);
    qo[i] = pack2(q0 * eb, q1 * eb);
    ko[i] = pack2(k0 * ei, k1 * ei);
    const u32 kdp = pack2(k0 * kd, k1 * kd);
    const int sw = ((tch ^ (((c16 & 1) << 2) | i)) << 4);
    *reinterpret_cast<u16*>(kcol + (2 * i) * 128 + sw) = (u16)(kdp & 0xffffu);
    *reinterpret_cast<u16*>(kcol + (2 * i + 1) * 128 + sw) = (u16)(kdp >> 16);
  }
  *reinterpret_cast<uint4*>(Qs + ofs) = make_uint4(qo[0], qo[1], qo[2], qo[3]);
  *reinterpret_cast<uint4*>(Ks + ofs) = make_uint4(ko[0], ko[1], ko[2], ko[3]);
}
__device__ __forceinline__ void stage_chunk(char* Qs, char* Ks, char* KdT, char* VT, char* LRb, const int tid, const uint4 rq0,
                                            const uint4 rq1, const uint4 rk0, const uint4 rk1, const uint4 rv0,
                                            const uint4 rv1, const uint4 rv2, const uint4 rv3, const uint4 rl,
                                            const bool ret, const int dir, const float ld) {
  const int tk = tid >> 3, c16 = tid & 7;
  const int ofs = tk * 128 + ((c16 ^ ((tk >> 1) & 7)) << 4);
  if (!ret) {
    *reinterpret_cast<uint4*>(Qs + ofs) = rq0;
    *reinterpret_cast<uint4*>(Ks + ofs) = rk0;
    *reinterpret_cast<uint4*>(Qs + ofs + 4096) = rq1;
    *reinterpret_cast<uint4*>(Ks + ofs + 4096) = rk1;
  } else {
    const float kdsc = __expf(64.f * ld);
    stage_ret_row(Qs, Ks, KdT, ofs, tk, c16, rq0, rk0, dir ? ld * (float)(64 - tk) : ld * (float)(tk + 1), kdsc);
    stage_ret_row(Qs, Ks, KdT, ofs + 4096, tk + 32, c16, rq1, rk1, dir ? ld * (float)(32 - tk) : ld * (float)(tk + 33), kdsc);
  }
  stage_v(VT, tid, rv0, rv1, tid >> 5);
  stage_v(VT, tid, rv2, rv3, (tid >> 5) + 8);
  (void)LRb; (void)rl;
}

__device__ __forceinline__ bool rec_is_heavy(int bid) { return bid < 128; }
__device__ __forceinline__ int rec_light_index(int bid) { return bid - 128; }

__device__ void rec_phase(const P& p, char* smem, const int item, unsigned* gate, const unsigned gate_target = 136u) {
  const int tid = opaque_tid(), lane = tid & 63, w = tid >> 6, l15 = lane & 15, quad = lane >> 4;
  const int sx = (l15 >> 1) & 7;
  char* Qs = smem;
  char* Ks = smem + 8192;
  char* KdT = smem + 16384;
  char* VT = smem + 24576;
  char* SC = smem + 40960;
  char* ST = smem + 49152;
  char* LRb = smem + 65536;
  float* TOT = (float*)(smem + 69632);
  float* DEC = (float*)(smem + 70656);

  if (gate != nullptr) {
    if (tid == 0) {
      unsigned sp = 0;
      while (xb_ld(gate) < gate_target) { __builtin_amdgcn_s_sleep(4); if (++sp > (1u << 22)) break; }
      __builtin_amdgcn_fence(__ATOMIC_ACQUIRE, "agent");
      asm volatile("s_waitcnt vmcnt(0)" ::: "memory");
    }
    __syncthreads();
  }
  for (int once_ = 0; once_ < 1; ++once_) {
    const int it = item;
    const bool sample = it < 128;
    const int id = sample ? it : it - 128;
    const int dir = id & 1, hg = (id >> 1) & 7, b = id >> 4;
    const int row0 = sample ? NCTX + b * 2048 : b * 256;
    const int nch = sample ? 32 : 4;
    const bool gla = hg >= 4;
    const int hh = hg & 3;
    const int qcol = gla ? 1536 + hh * 64 : hh * 64;
    const int kcol = gla ? 1792 + hh * 64 : 256 + hh * 64;
    const int vcol = gla ? 2048 + hh * 128 : 512 + hh * 128;
    const int lrcol = 3072 + dir * 16;
    u16* obuf = dir ? p.ob : p.of;

    bf16x8 wafr[4];
    float bav[4];
    float ld = 0.f;
#pragma unroll
    for (int dt = 0; dt < 4; ++dt) {
      wafr[dt] = (bf16x8){0, 0, 0, 0, 0, 0, 0, 0};
      bav[dt] = 0.f;
    }
    if (gla) {
      int lo2_ = hh * 64 + l15;
      asm volatile("" : "+v"(lo2_));
      const uint4* wt_ = p.watab + ((dir * 4 + hh) * 4) * 64 + lane;
#pragma unroll
      for (int dt = 0; dt < 4; ++dt) {
        bav[dt] = p.gla_ba[dir * 256 + lo2_ + dt * 16];
        uint4 wv = wt_[dt * 64];
        wafr[dt] = *reinterpret_cast<bf16x8*>(&wv);
      }
    } else {
      ld = p.ret_ld[dir * 4 + hh];
    }

    f32x4 S[4][2];
    if (sample) {
      int lo_ = quad * 512 + 32 * w + l15;
      asm volatile("" : "+v"(lo_));
      const float* sp = (gla ? p.state_gla : p.state_ret) + (size_t)((b * 2 + dir) * 4 + hh) * 8192 + lo_;
#pragma unroll
      for (int dt = 0; dt < 4; ++dt)
#pragma unroll
        for (int et = 0; et < 2; ++et)
#pragma unroll
          for (int jj = 0; jj < 4; ++jj)
            S[dt][et][jj] = sp[dt * 2048 + jj * 128 + et * 16];
    } else {
#pragma unroll
      for (int dt = 0; dt < 4; ++dt)
#pragma unroll
        for (int et = 0; et < 2; ++et) S[dt][et] = (f32x4){0.f, 0.f, 0.f, 0.f};
    }
#pragma unroll
    for (int dt = 0; dt < 4; ++dt)
#pragma unroll
      for (int et = 0; et < 2; ++et) {
        int e = 32 * w + et * 16 + l15, d0 = dt * 16 + quad * 4;
        uint2 o;
        o.x = pack2(S[dt][et][0], S[dt][et][1]);
        o.y = pack2(S[dt][et][2], S[dt][et][3]);
        *reinterpret_cast<uint2*>(ST + e * 128 + (((d0 >> 3) ^ sx) << 4) + (d0 & 7) * 2) = o;
      }

    uint4 rq0, rq1, rk0, rk1, rv0, rv1, rv2, rv3, rl;
    rl = make_uint4(0, 0, 0, 0);
    int c = dir ? nch - 1 : 0;
    const int cstep = dir ? -1 : 1;
    const u16* pq0 = p.proj + (size_t)(row0 + (tid >> 3)) * NPROJ + (tid & 7) * 8;
    const u16* pv0 = p.proj + (size_t)(row0 + 2 * (tid & 31)) * NPROJ + vcol + (tid >> 5) * 8;
    const u16* pl0 = p.proj + (size_t)(row0 + 16 * w + l15) * NPROJ + lrcol + (quad & 1) * 8;
#define PREFETCH(cc)                                                            \
  {                                                                             \
    const size_t co_ = (size_t)(cc) * 64 * NPROJ;                               \
    rq0 = *reinterpret_cast<const uint4*>(pq0 + co_ + qcol);                    \
    rk0 = *reinterpret_cast<const uint4*>(pq0 + co_ + kcol);                    \
    rq1 = *reinterpret_cast<const uint4*>(pq0 + co_ + 32 * NPROJ + qcol);       \
    rk1 = *reinterpret_cast<const uint4*>(pq0 + co_ + 32 * NPROJ + kcol);       \
    rv0 = *reinterpret_cast<const uint4*>(pv0 + co_);                           \
    rv1 = *reinterpret_cast<const uint4*>(pv0 + co_ + NPROJ);                   \
    rv2 = *reinterpret_cast<const uint4*>(pv0 + co_ + 64);                      \
    rv3 = *reinterpret_cast<const uint4*>(pv0 + co_ + 64 + NPROJ);              \
    rl = *reinterpret_cast<const uint4*>(pl0 + co_);                            \
  }
    float gv[4][4];
    float Eq[4];
    if (!gla && tid < 64) DEC[tid] = __expf(64.f * ld);
    PREFETCH(c);
    stage_chunk(Qs, Ks, KdT, VT, LRb, tid, rq0, rq1, rk0, rk1, rv0, rv1, rv2, rv3, rl, !gla, dir, ld);
    {
        if (gla) {
          bf16x8 afr = (bf16x8){0, 0, 0, 0, 0, 0, 0, 0};
          if (quad < 2) afr = *reinterpret_cast<const bf16x8*>(&rl);
#pragma unroll
          for (int dt = 0; dt < 4; ++dt) {
            f32x4 z = MFMA(afr, wafr[dt], ((f32x4){0.f, 0.f, 0.f, 0.f}));
#pragma unroll
            for (int j = 0; j < 4; ++j) {
              float zz = z[j] + bav[dt];
              gv[dt][j] = (fminf(zz, 0.f) - __logf(1.f + __expf(-fabsf(zz)))) * (1.f / 16.f);
            }
          }
#pragma unroll
          for (int dt = 0; dt < 4; ++dt) {
            gv[dt][1] += gv[dt][0];
            gv[dt][2] += gv[dt][1];
            gv[dt][3] += gv[dt][2];
            const float T = gv[dt][3];
            const float x1 = __shfl_up(T, 16, 64), x2 = __shfl_up(T, 32, 64), x3 = __shfl_up(T, 48, 64);
            const float E = (quad >= 1 ? x1 : 0.f) + (quad >= 2 ? x2 : 0.f) + (quad >= 3 ? x3 : 0.f);
            Eq[dt] = E;
            const float Wt = __shfl(E + T, 48 + l15, 64);
            if (quad == 0) TOT[w * 64 + dt * 16 + l15] = Wt;
          }
        } else {
#pragma unroll
          for (int dt = 0; dt < 4; ++dt) {
#pragma unroll
            for (int j = 0; j < 4; ++j) gv[dt][j] = ld * (float)(j + 1);
            Eq[dt] = ld * (float)(4 * quad);
          }
        }
    }
    __syncthreads();
    for (int s = 0; s < nch; ++s, c += cstep) {
      const int rb = row0 + c * 64;
      {
        const int cn_ = (s + 1 < nch) ? (c + cstep) : c;
        PREFETCH(cn_);
      }
      if (gla) {
      {
        int qofs = (16 * w + quad * 4) * 128 + (l15 & 7) * 2;
        asm volatile("" : "+v"(qofs));
        float ebs[4], eis[4], ebt = 1.f;
#pragma unroll
        for (int dt = 0; dt < 4; ++dt) {
          const int d = dt * 16 + l15;
          if (gla || dt == 0) {
            float btot, off;
            if (gla) {
              const float t0 = TOT[d], t1 = TOT[64 + d], t2 = TOT[128 + d], t3 = TOT[192 + d];
              btot = t0 + t1 + t2 + t3;
              off = (w > 0 ? t0 : 0.f) + (w > 1 ? t1 : 0.f) + (w > 2 ? t2 : 0.f);
            } else {
              btot = 64.f * ld;
              off = ld * (float)(16 * w);
            }
            ebt = __expf(btot);
            const float base = off + Eq[dt];
#pragma unroll
            for (int j = 0; j < 4; ++j) {
              const float exj = (j == 0) ? 0.f : gv[dt][j - 1];
              const float bb = dir ? (btot - base - exj) : (base + gv[dt][j]);
              ebs[j] = __expf(bb);
              eis[j] = __builtin_amdgcn_rcpf(ebs[j]);
            }
          }
          if (w == 0 && quad == 0) DEC[d] = ebt;
          float kdv[4];
#pragma unroll
          for (int j = 0; j < 4; ++j) {
            const float eb = ebs[j];
            const float ei = eis[j];
            const int ofs = qofs + j * 128 + (((dt * 2 + (l15 >> 3)) ^ (quad * 2 + (j >> 1))) << 4);
            const float q = __uint_as_float((u32)(*reinterpret_cast<const u16*>(Qs + ofs)) << 16);
            const float k = __uint_as_float((u32)(*reinterpret_cast<const u16*>(Ks + ofs)) << 16);
            const float ki = k * ei;
            const u32 pk = pack2(q * eb, ki);
            *reinterpret_cast<u16*>(Qs + ofs) = (u16)(pk & 0xffffu);
            *reinterpret_cast<u16*>(Ks + ofs) = (u16)(pk >> 16);
            kdv[j] = ki * ebt;
          }
          uint2 kd2;
          kd2.x = pack2(kdv[0], kdv[1]);
          kd2.y = pack2(kdv[2], kdv[3]);
          *reinterpret_cast<uint2*>(KdT + d * 128 + (((2 * w + (quad >> 1)) ^ ((d >> 1) & 7)) << 4) + (quad & 1) * 8) = kd2;
        }
      }
      __syncthreads();
      }
      {
        f32x4 sacc[4];
#pragma unroll
        for (int jt = 0; jt < 4; ++jt) sacc[jt] = (f32x4){0.f, 0.f, 0.f, 0.f};
        int irow = 16 * w + l15;
        asm volatile("" : "+v"(irow));
        const int sgn = dir ? -1 : 1;
#pragma unroll
        for (int kk = 0; kk < 2; ++kk) {
          bf16x8 bq = ldfrag(Qs, irow, kk * 4 + quad, sx);
#pragma unroll
          for (int jt = 0; jt < 4; ++jt) {
            bf16x8 ak = ldfrag(Ks, jt * 16 + l15, kk * 4 + quad, sx);
            sacc[jt] = MFMA(ak, bq, sacc[jt]);
          }
        }
#pragma unroll
        for (int jt = 0; jt < 4; ++jt) {
          const int j0 = jt * 16 + quad * 4;
          float v[4];
          const int rel_ = (jt - w) * sgn;
          if (rel_ < 0) {
#pragma unroll
            for (int jj = 0; jj < 4; ++jj) v[jj] = sacc[jt][jj];
          } else if (rel_ > 0) {
#pragma unroll
            for (int jj = 0; jj < 4; ++jj) v[jj] = 0.f;
          } else {
#pragma unroll
            for (int jj = 0; jj < 4; ++jj) {
              int j = j0 + jj;
              bool keep = (j - irow) * sgn <= 0;
              v[jj] = keep ? sacc[jt][jj] : 0.f;
            }
          }
          uint2 o;
          o.x = pack2(v[0], v[1]);
          o.y = pack2(v[2], v[3]);
          *reinterpret_cast<uint2*>(SC + irow * 128 + (((j0 >> 3) ^ sx) << 4) + (j0 & 7) * 2) = o;
        }
      }
      __syncthreads();
      {
        f32x4 o[2][4];
#pragma unroll
        for (int et = 0; et < 2; ++et)
#pragma unroll
          for (int i4 = 0; i4 < 4; ++i4) o[et][i4] = (f32x4){0.f, 0.f, 0.f, 0.f};
        bf16x8 vt[2][2];
#pragma unroll
        for (int et = 0; et < 2; ++et)
#pragma unroll
          for (int kk = 0; kk < 2; ++kk) vt[et][kk] = ldfrag(VT, 32 * w + et * 16 + l15, kk * 4 + quad, sx);
#pragma unroll
        for (int kk = 0; kk < 2; ++kk)
#pragma unroll
          for (int i4 = 0; i4 < 4; ++i4) {
            bf16x8 scf = ldfrag(SC, i4 * 16 + l15, kk * 4 + quad, sx);
#pragma unroll
            for (int et = 0; et < 2; ++et) o[et][i4] = MFMA(vt[et][kk], scf, o[et][i4]);
          }
        asm volatile("" ::: "memory");
#pragma unroll
        for (int kk = 0; kk < 2; ++kk) {
          bf16x8 stf[2];
#pragma unroll
          for (int et = 0; et < 2; ++et) stf[et] = ldfrag(ST, 32 * w + et * 16 + l15, kk * 4 + quad, sx);
#pragma unroll
          for (int i4 = 0; i4 < 4; ++i4) {
            bf16x8 qf = ldfrag(Qs, i4 * 16 + l15, kk * 4 + quad, sx);
#pragma unroll
            for (int et = 0; et < 2; ++et) o[et][i4] = MFMA(stf[et], qf, o[et][i4]);
          }
          asm volatile("" ::: "memory");
        }
#pragma unroll
        for (int et = 0; et < 2; ++et)
#pragma unroll
          for (int i4 = 0; i4 < 4; ++i4) {
            int e0 = 32 * w + et * 16 + quad * 4;
            int i = i4 * 16 + l15;
            uint2 ov;
            ov.x = pack2(o[et][i4][0], o[et][i4][1]);
            ov.y = pack2(o[et][i4][2], o[et][i4][3]);
            *reinterpret_cast<uint2*>(obuf + (size_t)(rb + i) * 1024 + hg * 128 + e0) = ov;
          }
        asm volatile("" ::: "memory");
#pragma unroll
        for (int dt = 0; dt < 4; ++dt) {
          f32x4 dc = *reinterpret_cast<const f32x4*>(DEC + dt * 16 + quad * 4);
#pragma unroll
          for (int et = 0; et < 2; ++et) S[dt][et] *= dc;
        }
#pragma unroll
        for (int kk = 0; kk < 2; ++kk)
#pragma unroll
          for (int dt = 0; dt < 4; ++dt) {
            bf16x8 kf = ldfrag(KdT, dt * 16 + l15, kk * 4 + quad, sx);
#pragma unroll
            for (int et = 0; et < 2; ++et) S[dt][et] = MFMA(kf, vt[et][kk], S[dt][et]);
          }
#pragma unroll
        for (int dt = 0; dt < 4; ++dt)
#pragma unroll
          for (int et = 0; et < 2; ++et) {
            int e = 32 * w + et * 16 + l15, d0 = dt * 16 + quad * 4;
            uint2 ov;
            ov.x = pack2(S[dt][et][0], S[dt][et][1]);
            ov.y = pack2(S[dt][et][2], S[dt][et][3]);
            *reinterpret_cast<uint2*>(ST + e * 128 + (((d0 >> 3) ^ sx) << 4) + (d0 & 7) * 2) = ov;
          }
      }
      __syncthreads();
      stage_chunk(Qs, Ks, KdT, VT, LRb, tid, rq0, rq1, rk0, rk1, rv0, rv1, rv2, rv3, rl, !gla, dir, ld);
      {
        if (gla) {
          bf16x8 afr = (bf16x8){0, 0, 0, 0, 0, 0, 0, 0};
          if (quad < 2) afr = *reinterpret_cast<const bf16x8*>(&rl);
#pragma unroll
          for (int dt = 0; dt < 4; ++dt) {
            f32x4 z = MFMA(afr, wafr[dt], ((f32x4){0.f, 0.f, 0.f, 0.f}));
#pragma unroll
            for (int j = 0; j < 4; ++j) {
              float zz = z[j] + bav[dt];
              gv[dt][j] = (fminf(zz, 0.f) - __logf(1.f + __expf(-fabsf(zz)))) * (1.f / 16.f);
            }
          }
#pragma unroll
          for (int dt = 0; dt < 4; ++dt) {
            gv[dt][1] += gv[dt][0];
            gv[dt][2] += gv[dt][1];
            gv[dt][3] += gv[dt][2];
            const float T = gv[dt][3];
            const float x1 = __shfl_up(T, 16, 64), x2 = __shfl_up(T, 32, 64), x3 = __shfl_up(T, 48, 64);
            const float E = (quad >= 1 ? x1 : 0.f) + (quad >= 2 ? x2 : 0.f) + (quad >= 3 ? x3 : 0.f);
            Eq[dt] = E;
            const float Wt = __shfl(E + T, 48 + l15, 64);
            if (quad == 0) TOT[w * 64 + dt * 16 + l15] = Wt;
          }
        } else {
#pragma unroll
          for (int dt = 0; dt < 4; ++dt) {
#pragma unroll
            for (int j = 0; j < 4; ++j) gv[dt][j] = ld * (float)(j + 1);
            Eq[dt] = ld * (float)(4 * quad);
          }
        }
      }
      __syncthreads();
    }
#undef PREFETCH
    if (!sample) {
      int lo_ = quad * 512 + 32 * w + l15;
      asm volatile("" : "+v"(lo_));
      float* dp = p.out + (gla ? OFF_SG : OFF_SR) + (size_t)((b * 2 + dir) * 4 + hh) * 8192 + lo_;
#pragma unroll
      for (int dt = 0; dt < 4; ++dt)
#pragma unroll
        for (int et = 0; et < 2; ++et)
#pragma unroll
          for (int jj = 0; jj < 4; ++jj)
            dp[dt * 2048 + jj * 128 + et * 16] = S[dt][et][jj];
    }
  }
}

__device__ void mix_phase(const P& p, int bid, int nb) {
  const int tid_ = opaque_tid();
  const int lane = tid_ & 63, wid = tid_ >> 6;
  const int col0 = lane * 16, hg = lane >> 3;
  const int nw = nb * 4;
  const int zoff = 1024 + (hg < 4 ? col0 : col0 + 1024);
  float gwv[16];
#pragma unroll
  for (int i = 0; i < 16; ++i) gwv[i] = (hg < 4) ? 1.f : p.gla_nw[(col0 & 127) + i];
  for (int r0 = bid * 4 + wid; r0 < NROWS / 2; r0 += nw) {
    uint4 f0[2], f1[2], b0[2], b1[2], z0[2], z1[2];
#pragma unroll
    for (int u = 0; u < 2; ++u) {
      const int row = r0 + u * (NROWS / 2);
      const uint4* pf = reinterpret_cast<const uint4*>(p.of + (size_t)row * 1024 + col0);
      const uint4* pb = reinterpret_cast<const uint4*>(p.ob + (size_t)row * 1024 + col0);
      const uint4* pz = reinterpret_cast<const uint4*>(p.proj + (size_t)row * NPROJ + zoff);
      f0[u] = pf[0]; f1[u] = pf[1]; b0[u] = pb[0]; b1[u] = pb[1]; z0[u] = pz[0]; z1[u] = pz[1];
    }
#pragma unroll
    for (int u = 0; u < 2; ++u) {
      const int row = r0 + u * (NROWS / 2);
      const u32 fw[8] = {f0[u].x, f0[u].y, f0[u].z, f0[u].w, f1[u].x, f1[u].y, f1[u].z, f1[u].w};
      const u32 bw[8] = {b0[u].x, b0[u].y, b0[u].z, b0[u].w, b1[u].x, b1[u].y, b1[u].z, b1[u].w};
      const u32 zw[8] = {z0[u].x, z0[u].y, z0[u].z, z0[u].w, z1[u].x, z1[u].y, z1[u].z, z1[u].w};
      float o[16];
      float s1 = 0.f;
#pragma unroll
      for (int i = 0; i < 8; ++i) {
        o[2 * i] = bflo(fw[i]) + bflo(bw[i]);
        o[2 * i + 1] = bfhi(fw[i]) + bfhi(bw[i]);
        s1 += o[2 * i] + o[2 * i + 1];
      }
      s1 += __shfl_xor(s1, 1, 64);
      s1 += __shfl_xor(s1, 2, 64);
      s1 += __shfl_xor(s1, 4, 64);
      const float mu = (hg < 4) ? s1 * (1.f / 128.f) : 0.f;
      float s2 = 0.f;
#pragma unroll
      for (int i = 0; i < 16; ++i) { float dlt = o[i] - mu; s2 += dlt * dlt; }
      s2 += __shfl_xor(s2, 1, 64);
      s2 += __shfl_xor(s2, 2, 64);
      s2 += __shfl_xor(s2, 4, 64);
      const float rs = rsqrtf(s2 * (1.f / 128.f) + EPS);
      u32 ow[8];
#pragma unroll
      for (int i = 0; i < 8; ++i) {
        float za = bflo(zw[i]), zb = bfhi(zw[i]);
        float ya = (o[2 * i] - mu) * rs * gwv[2 * i] * (za * __builtin_amdgcn_rcpf(1.f + __expf(-za)));
        float yb = (o[2 * i + 1] - mu) * rs * gwv[2 * i + 1] * (zb * __builtin_amdgcn_rcpf(1.f + __expf(-zb)));
        ow[i] = pack2(ya, yb);
      }
      uint4* po = reinterpret_cast<uint4*>(p.h + (size_t)row * 1024 + col0);
      po[0] = make_uint4(ow[0], ow[1], ow[2], ow[3]);
      po[1] = make_uint4(ow[4], ow[5], ow[6], ow[7]);
    }
  }
}

__device__ void final_phase(const P& p, int bid, int nb) {
  const int tid_ = opaque_tid();
  const int lane = tid_ & 63, wid = tid_ >> 6;
  const int nw = nb * 4;
  float4 fw[4];
#pragma unroll
  for (int i = 0; i < 4; ++i) fw[i] = reinterpret_cast<const float4*>(p.fnw)[lane + 64 * i];
  for (int r0 = bid * 4 + wid; r0 < NROWS / 2; r0 += nw) {
    float4 v[2][4];
#pragma unroll
    for (int u = 0; u < 2; ++u)
#pragma unroll
      for (int i = 0; i < 4; ++i)
        v[u][i] = reinterpret_cast<const float4*>(p.out + (size_t)(r0 + u * (NROWS / 2)) * 1024)[lane + 64 * i];
#pragma unroll
    for (int u = 0; u < 2; ++u) {
      float4* yr = reinterpret_cast<float4*>(p.out + (size_t)(r0 + u * (NROWS / 2)) * 1024);
      float ss = 0.f;
#pragma unroll
      for (int i = 0; i < 4; ++i)
        ss += v[u][i].x * v[u][i].x + v[u][i].y * v[u][i].y + v[u][i].z * v[u][i].z + v[u][i].w * v[u][i].w;
      ss = wave_sum(ss);
      const float r = rsqrtf(ss * (1.f / 1024.f) + EPS);
#pragma unroll
      for (int i = 0; i < 4; ++i)
        yr[lane + 64 * i] = make_float4(v[u][i].x * r * fw[i].x, v[u][i].y * r * fw[i].y, v[u][i].z * r * fw[i].z,
                                        v[u][i].w * r * fw[i].w);
    }
  }
}

template <int PH>
__device__ __forceinline__ void run_phase(const P& p, int bid, int nb, char* smem) {
  if (PH == 0) phase0(p, bid, nb, smem);
  if (PH == 1) phase1(p, bid, nb);
  if (PH == 2) gemm_phase<1>(p, bid & 7, bid >> 3, nb >> 3, smem, 0);
  if (PH == 3) rec_phase(p, smem, bid, nullptr);
  if (PH == 4) mix_phase(p, bid, nb);
  if (PH == 5) gemm_phase<2>(p, bid & 7, bid >> 3, nb >> 3, smem, 2);
  if (PH == 6) final_phase(p, bid, nb);
}

#if MULTI_LAUNCH
template <int PH>
__global__ void __launch_bounds__(256, 2) phase_kernel(P p) {
  extern __shared__ __attribute__((aligned(16))) char smem[];
  run_phase<PH>(p, blockIdx.x, gridDim.x, smem);
}
#else
__global__ void __launch_bounds__(256, 2) mega_kernel(P p) {
  extern __shared__ __attribute__((aligned(16))) char smem[];
  __shared__ uint4 xb_words;
  if (threadIdx.x == 0) xb_words = make_uint4(0u, 0u, 0u, 0u);
  __syncthreads();
  XcdBarrier xb = xcd_barrier_post(p.bar, (volatile LAS unsigned*)&xb_words);
  const int bid = blockIdx.x, nb = gridDim.x;
  run_phase<0>(p, bid, nb, smem);
  xcd_barrier(xb);
  run_phase<1>(p, bid, nb, smem);
  xcd_barrier(xb);
  {
    const bool heavy = rec_is_heavy(bid);
    const int g_ = bid & 7, l_ = bid >> 3;
    const bool hgla = (l_ >> 1) >= 4;
    unsigned* gq = p.bar + 3520 + g_ * 64;
    int* sWork = reinterpret_cast<int*>(smem + 71168);
    bool scanned = !heavy;
#pragma nounroll
    for (;;) {
      int kind = 0, tm = 4, mtx = 0, ntx = 0, item = 0, post = 0;
      unsigned* gate = nullptr;
      unsigned gtarget = 0u;
      __syncthreads();
      if (threadIdx.x == 0) {
        int go = 0;
        if (!scanned) go = (xb_ld(gq + 16) >= (hgla ? 144u : 272u)) ? 1 : 0;
        sWork[1] = go;
        sWork[0] = go ? 0 : (int)xb_add(gq + 16, 1u);
      }
      __syncthreads();
      const int go_ = __builtin_amdgcn_readfirstlane(sWork[1]);
      const int wk = __builtin_amdgcn_readfirstlane(sWork[0]);
      if (go_) {
        kind = 1; item = (g_ << 4) | l_; scanned = true;
        gate = hgla ? (gq + 32) : (gq + 36); gtarget = hgla ? 144u : 128u;
      } else if (wk >= 664) {
        if (scanned) break;
        continue;
      } else if (wk < 144) { const int j_ = wk >> 4; ntx = (j_ < 8) ? 12 + j_ : 24; mtx = 64 + 16 * g_ + (wk & 15); tm = 3; post = 32; }
      else if (wk < 272) { const int u_ = wk - 144; ntx = u_ >> 4; mtx = 64 + 16 * g_ + (u_ & 15); tm = 3; post = 36; }
      else if (wk < 408) { const int u_ = wk - 272, j_ = u_ >> 3; ntx = (j_ < 8) ? j_ : (j_ < 16 ? j_ + 4 : 24); mtx = 8 * g_ + (u_ & 7); tm = 3; post = 40; }
      else if (wk >= 456 && wk < 520) { kind = 1; const int r_ = wk - 456; item = 128 + (((4 * g_ + (r_ >> 4)) << 4) | (r_ & 15)); gate = gq + 40; gtarget = 136u; }
      else {
        const int v_ = (wk < 456) ? wk - 408 : wk - 520 + 48;
        if (v_ < 64) { const int j_ = v_ >> 3; ntx = (j_ < 4) ? 8 + j_ : 16 + j_; mtx = 8 * g_ + (v_ & 7); }
        else { const int u_ = v_ - 64, j_ = u_ >> 4; ntx = (j_ < 4) ? 8 + j_ : 16 + j_; mtx = 64 + 16 * g_ + (u_ & 15); }
      }
      if (kind == 0) gemm_phase<1>(p, g_, 0, 1, smem, tm, mtx, ntx);
      else rec_phase(p, smem, item, gate, gtarget);
      if (post) {
        asm volatile("s_waitcnt vmcnt(0)" ::: "memory");
        __syncthreads();
        if (threadIdx.x == 0) xb_add(gq + post, 1u);
      }
    }
  }
  xcd_barrier(xb);
  run_phase<4>(p, bid, nb, smem);
  xcd_barrier(xb);
  run_phase<5>(p, bid, nb, smem);
}
#endif

extern "C" void kernel_launch(void* const* d_in, const int* in_sizes, int n_in, void* d_out, int out_size,
                              void* d_ws, size_t ws_size, hipStream_t stream) {
  constexpr size_t WS_MOD = 0, WS_ROPE = 131072, WS_WTIN = 262144, WS_WTOUT = WS_WTIN + 6553600,
                   WS_H = WS_WTOUT + 2097152, WS_PROJ = WS_H + 50331648, WS_END = WS_PROJ + (size_t)NROWS * NPROJ * 2;
  if (ws_size < WS_END + 32768 || n_in != 15) { fprintf(stderr, "kernel_launch: bad ws/n_in\n"); return; }
  P p{};
  p.x_prompt = (const float*)d_in[0]; p.x_sample = (const float*)d_in[1]; p.c = (const float*)d_in[2];
  p.state_ret = (const float*)d_in[3]; p.state_gla = (const float*)d_in[4]; p.c_ctx = (const float*)d_in[5];
  p.w_mod = (const float*)d_in[6]; p.b_mod = (const float*)d_in[7]; p.w_in = (const float*)d_in[8];
  p.ret_ld = (const float*)d_in[9]; p.gla_wa = (const float*)d_in[10]; p.gla_ba = (const float*)d_in[11];
  p.gla_nw = (const float*)d_in[12]; p.w_out = (const float*)d_in[13]; p.fnw = (const float*)d_in[14];
  p.out = (float*)d_out;
  char* ws = (char*)d_ws;
  p.mod = (float*)(ws + WS_MOD); p.rope = (float*)(ws + WS_ROPE); p.bar = (unsigned*)(ws + 114688); p.rowss = (float*)(ws + 147456); p.mcnt = (unsigned*)(ws + 245760);
  p.wt_in = (u16*)(ws + WS_WTIN); p.wt_out = (u16*)(ws + WS_WTOUT);
  p.h = (u16*)(ws + WS_H); p.proj = (u16*)(ws + WS_PROJ); p.watab = (uint4*)(ws + WS_END);
  p.of = (u16*)d_out; p.ob = (u16*)d_out + (size_t)NROWS * 1024;
  (void)hipMemsetAsync(ws, 0, 262144, stream);
#if MULTI_LAUNCH
  static int inited = 0;
  if (!inited) {
    hipFuncSetAttribute((const void*)phase_kernel<0>, hipFuncAttributeMaxDynamicSharedMemorySize, LDS_BYTES);
    hipFuncSetAttribute((const void*)phase_kernel<1>, hipFuncAttributeMaxDynamicSharedMemorySize, LDS_BYTES);
    hipFuncSetAttribute((const void*)phase_kernel<2>, hipFuncAttributeMaxDynamicSharedMemorySize, LDS_BYTES);
    hipFuncSetAttribute((const void*)phase_kernel<3>, hipFuncAttributeMaxDynamicSharedMemorySize, LDS_BYTES);
    hipFuncSetAttribute((const void*)phase_kernel<4>, hipFuncAttributeMaxDynamicSharedMemorySize, LDS_BYTES);
    hipFuncSetAttribute((const void*)phase_kernel<5>, hipFuncAttributeMaxDynamicSharedMemorySize, LDS_BYTES);
    hipFuncSetAttribute((const void*)phase_kernel<6>, hipFuncAttributeMaxDynamicSharedMemorySize, LDS_BYTES);
    inited = 1;
  }
  const int G = 512;
  phase_kernel<0><<<G, 256, LDS_BYTES, stream>>>(p);
  phase_kernel<1><<<G, 256, LDS_BYTES, stream>>>(p);
  phase_kernel<2><<<G, 256, LDS_BYTES, stream>>>(p);
  phase_kernel<3><<<G, 256, LDS_BYTES, stream>>>(p);
  phase_kernel<4><<<G, 256, LDS_BYTES, stream>>>(p);
  phase_kernel<5><<<G, 256, LDS_BYTES, stream>>>(p);
  phase_kernel<6><<<G, 256, LDS_BYTES, stream>>>(p);
#else
  static int grid_blocks = 0;
  if (!grid_blocks) {
    int dev = 0, cus = 0, per_cu = 0;
    hipGetDevice(&dev);
    hipDeviceGetAttribute(&cus, hipDeviceAttributeMultiprocessorCount, dev);
    hipFuncSetAttribute((const void*)mega_kernel, hipFuncAttributeMaxDynamicSharedMemorySize, LDS_BYTES);
    hipOccupancyMaxActiveBlocksPerMultiprocessor(&per_cu, (const void*)mega_kernel, 256, LDS_BYTES);
    (void)per_cu;
    per_cu = 2;
    grid_blocks = cus * per_cu;
  }
  void* args[] = {&p};
  hipError_t e = hipLaunchCooperativeKernel((const void*)mega_kernel, dim3(grid_blocks), dim3(256), args, LDS_BYTES, stream);
  if (e != hipSuccess) fprintf(stderr, "cooperative launch failed: %s (grid %d)\n", hipGetErrorString(e), grid_blocks);
#endif
}
```

```cpp
#include <hip/hip_runtime.h>
#include <cstdio>

#ifndef MULTI_LAUNCH
#define MULTI_LAUNCH 0
#endif

typedef unsigned short u16;
typedef unsigned int u32;
using bf16x8 = __attribute__((ext_vector_type(8))) short;
using f32x4 = __attribute__((ext_vector_type(4))) float;

constexpr int NROWS = 24576;
constexpr int NCTX = 8192;
constexpr int NPROJ = 3104;
constexpr int LDS_BYTES = 73728;
constexpr size_t OFF_SR = (size_t)NROWS * 1024;
constexpr size_t OFF_SG = OFF_SR + 2097152;
constexpr float EPS = 1e-6f;

struct P {
  const float *x_prompt, *x_sample, *c, *state_ret, *state_gla, *c_ctx, *w_mod, *b_mod, *w_in, *ret_ld,
      *gla_wa, *gla_ba, *gla_nw, *w_out, *fnw;
  float* out;
  float* mod;
  float* rope;
  u16* wt_in;
  u16* wt_out;
  u16* h;
  u16* proj;
  u16* of;
  u16* ob;
  unsigned* bar;
  uint4* watab;
  float* rowss;
  unsigned* mcnt;
};

__device__ __forceinline__ u32 f2bf(float f) {
  u32 u = __float_as_uint(f);
  return (u + 0x7fffu + ((u >> 16) & 1u)) >> 16;
}
typedef __bf16 bf16x2_t __attribute__((ext_vector_type(2)));
typedef float f32x2_t __attribute__((ext_vector_type(2)));
__device__ __forceinline__ u32 pack2(float a, float b) {
  f32x2_t v = {a, b};
  bf16x2_t r = __builtin_convertvector(v, bf16x2_t);
  return *reinterpret_cast<u32*>(&r);
}
__device__ __forceinline__ float bflo(u32 w) { return __uint_as_float(w << 16); }
__device__ __forceinline__ float bfhi(u32 w) { return __uint_as_float(w & 0xffff0000u); }
__device__ __forceinline__ float wave_sum(float v) {
#pragma unroll
  for (int m = 32; m >= 1; m >>= 1) v += __shfl_xor(v, m, 64);
  return v;
}
__device__ __forceinline__ bf16x8 ldfrag(const char* base, int row, int c16, int sx) {
  return *reinterpret_cast<const bf16x8*>(base + row * 128 + ((c16 ^ sx) << 4));
}
__device__ __forceinline__ int opaque_tid() { int t = threadIdx.x; asm volatile("" : "+v"(t)); return t; }
#define MFMA(a, b, c) __builtin_amdgcn_mfma_f32_16x16x32_bf16(a, b, c, 0, 0, 0)

#define XB_TMO      128
#define XB_XCNT(j)  (256  + 64 * (j))
#define XB_XSUB(j)  (1280 + 64 * (j))
#define XB_XGEN(j)  (2304 + 64 * (j))
#define XB_TOP      3328
#define XB_TOPGEN   3392
#define XCD_BAR_WORDS 3456
#define XB_SPIN_CAP (1u << 18)
#define LAS __attribute__((address_space(3)))
__device__ __forceinline__ unsigned xb_ld(unsigned* p) { return __hip_atomic_load(p, __ATOMIC_RELAXED, __HIP_MEMORY_SCOPE_AGENT); }
__device__ __forceinline__ unsigned xb_add(unsigned* p, unsigned v) { return __hip_atomic_fetch_add(p, v, __ATOMIC_RELAXED, __HIP_MEMORY_SCOPE_AGENT); }
__device__ __forceinline__ unsigned xb_xcc_id() { return (unsigned)__builtin_amdgcn_s_getreg((3 << 11) | 20) & 0xFu; }
#define XB_SPIN(cond, bar) do { unsigned _sp = 0; while (cond) { __builtin_amdgcn_s_sleep(1); \
    if ((++_sp & 255u) == 0u) { if (xb_ld(&(bar)[XB_TMO])) break; if (_sp > XB_SPIN_CAP) { atomicAdd(&(bar)[XB_TMO], 1u); break; } } } } while (0)
struct XcdBarrier { unsigned* bar; unsigned x; volatile LAS unsigned* st; };
__device__ __forceinline__ XcdBarrier xcd_barrier_post(unsigned* bar, volatile LAS unsigned* st) {
  XcdBarrier b; b.bar = bar; b.x = xb_xcc_id(); b.st = st;
  if (threadIdx.x == 0) (void)xb_add(&bar[XB_XCNT(b.x)], 1u);
  return b;
}
__device__ __forceinline__ void xcd_barrier_complete(unsigned* bar, unsigned x, unsigned& nloc, unsigned& nx) {
  const unsigned G = gridDim.x * gridDim.y * gridDim.z;
  unsigned sum, cnt, mine, sp = 0u;
  for (;;) {
    sum = 0u; cnt = 0u; mine = 0u;
#pragma unroll
    for (unsigned j = 0; j < 16; ++j) { const unsigned c = xb_ld(&bar[XB_XCNT(j)]); sum += c; cnt += (c > 0u) ? 1u : 0u; mine = (j == x) ? c : mine; }
    if (sum == G) break;
    __builtin_amdgcn_s_sleep(1);
    if ((++sp & 255u) == 0u) { if (xb_ld(&bar[XB_TMO])) break; if (sp > XB_SPIN_CAP) { atomicAdd(&bar[XB_TMO], 1u); break; } }
  }
  nloc = mine > 0u ? mine : 1u; nx = cnt > 0u ? cnt : 1u;
}
__device__ __forceinline__ void xcd_barrier(const XcdBarrier& b) {
  asm volatile("s_waitcnt vmcnt(0)" ::: "memory");
  __syncthreads();
  if (threadIdx.x == 0) {
    unsigned* bar = b.bar;
    __builtin_amdgcn_s_waitcnt(0);
    const unsigned bx = xb_xcc_id();
    unsigned nloc = b.st[0], nx = b.st[1];
    if (nloc == 0u) { xcd_barrier_complete(bar, bx, nloc, nx); b.st[0] = nloc; b.st[1] = nx; }
    const unsigned old = xb_add(&bar[XB_XSUB(bx)], 1u);
    const unsigned gen = old / nloc;
    if (old + 1u == (gen + 1u) * nloc) {
      __builtin_amdgcn_fence(__ATOMIC_RELEASE, "agent");
      asm volatile("s_waitcnt vmcnt(0)" ::: "memory");
      const unsigned og = xb_add(&bar[XB_TOP], 1u);
      const unsigned tg = og / nx;
      if (og + 1u == (tg + 1u) * nx) xb_add(&bar[XB_TOPGEN], 1u);
      else XB_SPIN(xb_ld(&bar[XB_TOPGEN]) == tg, bar);
      __builtin_amdgcn_fence(__ATOMIC_ACQUIRE, "agent");
      xb_add(&bar[XB_XGEN(bx)], 1u);
      asm volatile("s_waitcnt vmcnt(0)" ::: "memory");
    } else {
      XB_SPIN(xb_ld(&bar[XB_XGEN(bx)]) == gen, bar);
      __builtin_amdgcn_fence(__ATOMIC_ACQUIRE, "agent");
      asm volatile("s_waitcnt vmcnt(0)" ::: "memory");
    }
  }
  __syncthreads();
}

__device__ __forceinline__ void group_barrier(unsigned* ctr, unsigned n) {
  asm volatile("s_waitcnt vmcnt(0)" ::: "memory");
  __syncthreads();
  if (threadIdx.x == 0) {
    __builtin_amdgcn_fence(__ATOMIC_RELEASE, "agent");
    asm volatile("s_waitcnt vmcnt(0)" ::: "memory");
    xb_add(ctr, 1u);
    unsigned sp = 0;
    while (xb_ld(ctr) < n) { __builtin_amdgcn_s_sleep(8); if (++sp > (1u << 20)) break; }
    __builtin_amdgcn_fence(__ATOMIC_ACQUIRE, "agent");
    asm volatile("s_waitcnt vmcnt(0)" ::: "memory");
  }
  __syncthreads();
}

__device__ __forceinline__ void transpose_tile(const float* __restrict__ src, u16* __restrict__ dst, const int N,
                                               const int kt, const int ntile, char* smem, const int lane, const int wid) {
  float* tile = (float*)smem;
  const int k0 = kt * 64, n0 = ntile * 64;
  float tv_[16];
#pragma unroll
  for (int i = 0; i < 16; ++i) {
    int n = n0 + lane;
    tv_[i] = (n < N) ? src[(size_t)(k0 + wid + 4 * i) * N + n] : 0.f;
  }
#pragma unroll
  for (int i = 0; i < 16; ++i) tile[(wid + 4 * i) * 65 + lane] = tv_[i];
  __syncthreads();
  for (int i = wid; i < 64; i += 4)
    dst[(size_t)(n0 + i) * 1024 + k0 + lane] = (u16)f2bf(tile[lane * 65 + i]);
  __syncthreads();
}

__device__ void phase0(const P& p, int bid, int nb, char* smem) {
  const int tid = opaque_tid(), lane = tid & 63, wid = tid >> 6;
  const int NIT = 384 + 800 + 256 + 2;
  for (int it = bid; it < NIT; it += nb) {
    if (it < 384) {
      const int cb = it % 48, kc = it / 48;
      float* s = (float*)smem;
      float* red = s + 9 * 128;
      for (int i = tid; i < 9 * 128; i += 256) {
        int ci = i >> 7, kk = i & 127;
        int k = kc * 128 + kk;
        float v = (ci == 0) ? p.c_ctx[k] : p.c[(ci - 1) * 1024 + k];
        s[i] = v / (1.f + __expf(-v));
      }
      __syncthreads();
      float acc[9];
#pragma unroll
      for (int ci = 0; ci < 9; ++ci) acc[ci] = 0.f;
      const int col = cb * 64 + lane;
      const float* wp = p.w_mod + (size_t)(kc * 128 + wid * 32) * 3072 + col;
      float wv_[32];
#pragma unroll
      for (int kk = 0; kk < 32; ++kk) wv_[kk] = wp[(size_t)kk * 3072];
#pragma unroll
      for (int kk = 0; kk < 32; ++kk) {
        float w = wv_[kk];
#pragma unroll
        for (int ci = 0; ci < 9; ++ci) acc[ci] += s[ci * 128 + wid * 32 + kk] * w;
      }
#pragma unroll
      for (int ci = 0; ci < 9; ++ci) red[(wid * 9 + ci) * 64 + lane] = acc[ci];
      __syncthreads();
      for (int i = tid; i < 9 * 64; i += 256) {
        int ci = i >> 6, l = i & 63;
        float v = red[(0 * 9 + ci) * 64 + l] + red[(1 * 9 + ci) * 64 + l] + red[(2 * 9 + ci) * 64 + l] +
                  red[(3 * 9 + ci) * 64 + l];
        if (kc == 0) v += p.b_mod[cb * 64 + l];
        atomicAdd(&p.mod[ci * 3072 + cb * 64 + l], v);
      }
      __syncthreads();
    } else if (it < 384 + 800) {
      const int j = it - 384;
      transpose_tile(p.w_in, p.wt_in, NPROJ, j / 50, j % 50, smem, lane, wid);
    } else if (it < 384 + 800 + 256) {
      const int j = it - 384 - 800;
      transpose_tile(p.w_out, p.wt_out, 1024, j >> 4, j & 15, smem, lane, wid);
    } else if (it == 384 + 800 + 256 + 1) {
      for (int i = tid; i < 2048; i += 256) {
        const int ln = i & 63, dt = (i >> 6) & 3, hh = (i >> 8) & 3, dir = i >> 10;
        const int l15_ = ln & 15, quad_ = ln >> 4;
        uint4 wv = make_uint4(0u, 0u, 0u, 0u);
        if (quad_ < 2) {
          const float* wp_ = p.gla_wa + (size_t)(dir * 16 + quad_ * 8) * 256 + hh * 64 + dt * 16 + l15_;
          wv = make_uint4(pack2(wp_[0], wp_[256]), pack2(wp_[512], wp_[768]), pack2(wp_[1024], wp_[1280]), pack2(wp_[1536], wp_[1792]));
        }
        p.watab[i] = wv;
      }
    } else {
      for (int i = tid; i < 1024; i += 256) {
        int pos = i >> 4, f = i & 15;
        float inv = powf(10000.f, -(float)f / 16.f);
        float ang = (float)pos * inv;
        p.rope[i] = cosf(ang);
        p.rope[1024 + i] = sinf(ang);
      }
    }
  }
}

__device__ void phase1(const P& p, int bid, int nb) {
  const int tid_ = opaque_tid();
  const int lane = tid_ & 63, wid = tid_ >> 6;
  const int nw = nb * 4;
  for (int r0 = bid * 4 + wid; r0 < NROWS / 2; r0 += nw) {
    const float* xr[2];
    int ci[2];
#pragma unroll
    for (int u = 0; u < 2; ++u) {
      const int row = r0 + u * (NROWS / 2);
      if (row < NCTX) { xr[u] = p.x_prompt + (size_t)row * 1024; ci[u] = 0; }
      else { xr[u] = p.x_sample + (size_t)(row - NCTX) * 1024; ci[u] = 1 + ((row - NCTX) >> 11); }
    }
    float4 v[2][4];
#pragma unroll
    for (int u = 0; u < 2; ++u)
#pragma unroll
      for (int i = 0; i < 4; ++i) v[u][i] = reinterpret_cast<const float4*>(xr[u])[lane + 64 * i];
    float4 shv[2][4], scv[2][4];
#pragma unroll
    for (int u = 0; u < 2; ++u)
#pragma unroll
      for (int i = 0; i < 4; ++i) {
        const float* md_ = p.mod + ci[u] * 3072 + (lane + 64 * i) * 4;
        shv[u][i] = *reinterpret_cast<const float4*>(md_);
        scv[u][i] = *reinterpret_cast<const float4*>(md_ + 1024);
      }
    __builtin_amdgcn_sched_barrier(0);
#pragma unroll
    for (int u = 0; u < 2; ++u) {
      const int row = r0 + u * (NROWS / 2);
      float ss = 0.f;
#pragma unroll
      for (int i = 0; i < 4; ++i)
        ss += v[u][i].x * v[u][i].x + v[u][i].y * v[u][i].y + v[u][i].z * v[u][i].z + v[u][i].w * v[u][i].w;
      ss = wave_sum(ss);
      const float r = rsqrtf(ss * (1.f / 1024.f) + EPS);
#pragma unroll
      for (int i = 0; i < 4; ++i) {
        int col = (lane + 64 * i) * 4;
        const float4 sh = shv[u][i];
        const float4 sc = scv[u][i];
        uint2 o;
        o.x = pack2(v[u][i].x * r * (1.f + sc.x) + sh.x, v[u][i].y * r * (1.f + sc.y) + sh.y);
        o.y = pack2(v[u][i].z * r * (1.f + sc.z) + sh.z, v[u][i].w * r * (1.f + sc.w) + sh.w);
        *reinterpret_cast<uint2*>(p.h + (size_t)row * 1024 + col) = o;
      }
    }
  }
}

template <int MODE>
__device__ void gemm_phase(const P& p, const int xcd, const int local, const int nlocal, char* smem, const int tmode,
                           const int mt_x = 0, const int nt_x = 0) {
  constexpr int NT = (MODE == 1) ? 25 : 8;
  const u16* A = p.h;
  const u16* B = (MODE == 1) ? p.wt_in : p.wt_out;
  const int tid = opaque_tid(), lane = tid & 63, wid = tid >> 6, wr = wid >> 1, wc = wid & 1;
  const int l15 = lane & 15, quad = lane >> 4, sx = (l15 >> 1) & 7;
  const int lrow = tid >> 3, lc16 = tid & 7;
  const int wofs = lrow * 128 + ((lc16 ^ ((lrow >> 1) & 7)) << 4);
  const int ntiles = (tmode == 0) ? 320 : (tmode == 1 ? 280 : (tmode == 2 ? 192 : local + 1));
  for (int t = local; t < ntiles; t += nlocal) {
    int nt, mt;
    if (tmode == 0) {
      const int mg = t / 160, r_ = t % 160, j_ = r_ >> 3;
      nt = (j_ < 8) ? j_ : (j_ < 16 ? j_ + 4 : j_ + 5);
      mt = 64 + xcd * 16 + mg * 8 + (r_ & 7);
    } else if (tmode == 1) {
      if (t < 200) { nt = t >> 3; mt = xcd * 8 + (t & 7); }
      else { const int u_ = t - 200, mg = u_ / 40, r_ = u_ % 40, j_ = r_ >> 3; nt = (j_ < 4) ? 8 + j_ : 20; mt = 64 + xcd * 16 + mg * 8 + (r_ & 7); }
    } else if (tmode == 2) {
      const int mg = t >> 6, r_ = t & 63;
      nt = r_ >> 3; mt = xcd * 24 + mg * 8 + (r_ & 7);
    } else {
      nt = nt_x; mt = mt_x;
    }
    const int m0 = mt * 128, n0 = nt * 128;
    f32x4 acc[4][4];
#pragma unroll
    for (int a = 0; a < 4; ++a)
#pragma unroll
      for (int b = 0; b < 4; ++b) acc[a][b] = (f32x4){0.f, 0.f, 0.f, 0.f};
    const u16* ag = A + (size_t)(m0 + lrow) * 1024 + lc16 * 8;
    const u16* bg = B + (size_t)(n0 + lrow) * 1024 + lc16 * 8;
    uint4 ra0, ra1, ra2, ra3, rb0, rb1, rb2, rb3;
    uint4 sa0, sa1, sa2, sa3, sb0, sb1, sb2, sb3;
#define GLOAD(R, S, ksv)                                                              \
  {                                                                                   \
    const u16* a_ = ag + (ksv) * 64;                                                  \
    const u16* b_ = bg + (ksv) * 64;                                                  \
    R##0 = *reinterpret_cast<const uint4*>(a_);                                       \
    R##1 = *reinterpret_cast<const uint4*>(a_ + 32 * 1024);                           \
    R##2 = *reinterpret_cast<const uint4*>(a_ + 64 * 1024);                           \
    R##3 = *reinterpret_cast<const uint4*>(a_ + 96 * 1024);                           \
    S##0 = *reinterpret_cast<const uint4*>(b_);                                       \
    S##1 = *reinterpret_cast<const uint4*>(b_ + 32 * 1024);                           \
    S##2 = *reinterpret_cast<const uint4*>(b_ + 64 * 1024);                           \
    S##3 = *reinterpret_cast<const uint4*>(b_ + 96 * 1024);                           \
  }
#define LWRITE(buf, R, S)                                                             \
  {                                                                                   \
    char* d_ = smem + (buf) * 32768 + wofs;                                           \
    *reinterpret_cast<uint4*>(d_) = R##0;                                             \
    *reinterpret_cast<uint4*>(d_ + 4096) = R##1;                                      \
    *reinterpret_cast<uint4*>(d_ + 8192) = R##2;                                      \
    *reinterpret_cast<uint4*>(d_ + 12288) = R##3;                                     \
    *reinterpret_cast<uint4*>(d_ + 16384) = S##0;                                     \
    *reinterpret_cast<uint4*>(d_ + 16384 + 4096) = S##1;                              \
    *reinterpret_cast<uint4*>(d_ + 16384 + 8192) = S##2;                              \
    *reinterpret_cast<uint4*>(d_ + 16384 + 12288) = S##3;                             \
  }
#define COMPUTE(buf)                                                                  \
  {                                                                                   \
    const char* cur = smem + (buf) * 32768;                                           \
    _Pragma("unroll") for (int kk = 0; kk < 2; ++kk) {                                \
      bf16x8 af[4], bfr[4];                                                           \
      _Pragma("unroll") for (int ns = 0; ns < 4; ++ns)                                \
          af[ns] = ldfrag(cur + 16384, wc * 64 + ns * 16 + l15, kk * 4 + quad, sx);   \
      _Pragma("unroll") for (int ms = 0; ms < 4; ++ms)                                \
          bfr[ms] = ldfrag(cur, wr * 64 + ms * 16 + l15, kk * 4 + quad, sx);          \
      _Pragma("unroll") for (int ns = 0; ns < 4; ++ns)                                \
          _Pragma("unroll") for (int ms = 0; ms < 4; ++ms)                            \
              acc[ns][ms] = MFMA(af[ns], bfr[ms], acc[ns][ms]);                       \
    }                                                                                 \
  }
    f32x4 xpre[4][4];
    GLOAD(ra, rb, 0);
    GLOAD(sa, sb, 1);
    LWRITE(0, ra, rb);
    __syncthreads();
#pragma unroll
    for (int ks = 0; ks < 16; ks += 2) {
      if (ks + 2 < 16) GLOAD(ra, rb, ks + 2);
      if (MODE == 2 && ks == 14) {
        const float* xb_ = (m0 < NCTX) ? p.x_prompt : (p.x_sample - (size_t)NCTX * 1024);
        const float* xp_ = xb_ + (size_t)(m0 + wr * 64 + l15) * 1024 + (n0 + wc * 64 + quad * 4);
#pragma unroll
        for (int ns = 0; ns < 4; ++ns)
#pragma unroll
          for (int ms = 0; ms < 4; ++ms) xpre[ns][ms] = *reinterpret_cast<const f32x4*>(xp_ + (size_t)ms * 16 * 1024 + ns * 16);
      }
      __builtin_amdgcn_sched_barrier(0);
      COMPUTE(0);
      LWRITE(1, sa, sb);
      __syncthreads();
      if (ks + 3 < 16) GLOAD(sa, sb, ks + 3);
      __builtin_amdgcn_sched_barrier(0);
      COMPUTE(1);
      if (ks + 2 < 16) LWRITE(0, ra, rb);
      __syncthreads();
    }
#undef GLOAD
#undef LWRITE
#undef COMPUTE
    const int colbase = n0 + wc * 64;
    if (MODE == 1) {
      if (colbase < NPROJ) {
        const bool sample = m0 >= NCTX;
        const bool scaled = (colbase >= 256 && colbase < 512) || (colbase >= 1536 && colbase < 1792);
        if (scaled) {
#pragma unroll
          for (int a = 0; a < 4; ++a)
#pragma unroll
            for (int b = 0; b < 4; ++b) acc[a][b] *= 0.125f;
        }
        if (sample && colbase < 512) {
#pragma unroll
          for (int ms = 0; ms < 4; ++ms) {
            int m = m0 + wr * 64 + ms * 16 + l15;
            int tkn = (m - NCTX) & 2047;
            int r = tkn >> 6, c = tkn & 63;
            f32x4 c0 = *reinterpret_cast<const f32x4*>(p.rope + r * 16 + quad * 4);
            f32x4 s0 = *reinterpret_cast<const f32x4*>(p.rope + 1024 + r * 16 + quad * 4);
            f32x4 c1 = *reinterpret_cast<const f32x4*>(p.rope + c * 16 + quad * 4);
            f32x4 s1 = *reinterpret_cast<const f32x4*>(p.rope + 1024 + c * 16 + quad * 4);
            f32x4 x1 = acc[0][ms], x2 = acc[2][ms];
            acc[0][ms] = x1 * c0 - x2 * s0;
            acc[2][ms] = x2 * c0 + x1 * s0;
            x1 = acc[1][ms]; x2 = acc[3][ms];
            acc[1][ms] = x1 * c1 - x2 * s1;
            acc[3][ms] = x2 * c1 + x1 * s1;
          }
        }
#pragma unroll
        for (int ns = 0; ns < 4; ++ns) {
          int n = colbase + ns * 16 + quad * 4;
          if (n < NPROJ) {
#pragma unroll
            for (int ms = 0; ms < 4; ++ms) {
              int m = m0 + wr * 64 + ms * 16 + l15;
              uint2 o;
              o.x = pack2(acc[ns][ms][0], acc[ns][ms][1]);
              o.y = pack2(acc[ns][ms][2], acc[ns][ms][3]);
              if (tmode == 3)
                __hip_atomic_store(reinterpret_cast<unsigned long long*>(p.proj + (size_t)m * NPROJ + n),
                                   ((unsigned long long)o.y << 32) | o.x, __ATOMIC_RELAXED, __HIP_MEMORY_SCOPE_AGENT);
              else
                *reinterpret_cast<uint2*>(p.proj + (size_t)m * NPROJ + n) = o;
            }
          }
        }
      }
    } else {
      const int ci = (m0 < NCTX) ? 0 : 1 + ((m0 - NCTX) >> 11);
      const float* gate = p.mod + ci * 3072 + 2048;
#pragma unroll
      for (int ns = 0; ns < 4; ++ns) {
        int n = colbase + ns * 16 + quad * 4;
        f32x4 g = *reinterpret_cast<const f32x4*>(gate + n);
#pragma unroll
        for (int ms = 0; ms < 4; ++ms) {
          acc[ns][ms] = xpre[ns][ms] + g * acc[ns][ms];
        }
      }
#pragma unroll
      for (int ms = 0; ms < 4; ++ms) {
        float ssq = 0.f;
#pragma unroll
        for (int ns = 0; ns < 4; ++ns)
#pragma unroll
          for (int j = 0; j < 4; ++j) ssq += acc[ns][ms][j] * acc[ns][ms][j];
        ssq += __shfl_xor(ssq, 16, 64);
        ssq += __shfl_xor(ssq, 32, 64);
        if (quad == 0)
          (void)__hip_atomic_fetch_add(p.rowss + m0 + wr * 64 + ms * 16 + l15, ssq, __ATOMIC_RELAXED, __HIP_MEMORY_SCOPE_AGENT);
      }
      asm volatile("s_waitcnt vmcnt(0)" ::: "memory");
      __syncthreads();
      if (tid == 0) {
        xb_add(p.mcnt + mt, 1u);
        unsigned sp = 0;
        while (xb_ld(p.mcnt + mt) < 8u) { __builtin_amdgcn_s_sleep(2); if (++sp > (1u << 22)) break; }
      }
      __syncthreads();
#pragma unroll
      for (int ms = 0; ms < 4; ++ms) {
        const int m = m0 + wr * 64 + ms * 16 + l15;
        const float ssr = __hip_atomic_load(p.rowss + m, __ATOMIC_RELAXED, __HIP_MEMORY_SCOPE_AGENT);
        const float rn = rsqrtf(ssr * (1.f / 1024.f) + EPS);
#pragma unroll
        for (int ns = 0; ns < 4; ++ns) {
          const int n = colbase + ns * 16 + quad * 4;
          const f32x4 fwv = *reinterpret_cast<const f32x4*>(p.fnw + n);
          *reinterpret_cast<f32x4*>(p.out + (size_t)m * 1024 + n) = acc[ns][ms] * rn * fwv;
        }
      }
    }
  }
}

__device__ __forceinline__ void stage_v(char* VT, const int tid, const uint4 RA, const uint4 RB, const int e8) {
  const int pp = tid & 31;
  const u32 a0[4] = {RA.x, RA.y, RA.z, RA.w};
  const u32 a1[4] = {RB.x, RB.y, RB.z, RB.w};
#pragma unroll
  for (int ei = 0; ei < 8; ++ei) {
    int e = e8 * 8 + ei;
    const u32 pk = __builtin_amdgcn_perm(a1[ei >> 1], a0[ei >> 1], (ei & 1) ? 0x07060302u : 0x05040100u);
    int ofs = e * 128 + (((pp >> 2) ^ ((e >> 1) & 7)) << 4) + (pp & 3) * 4;
    *reinterpret_cast<u32*>(VT + ofs) = pk;
  }
}
__device__ __forceinline__ void stage_ret_row(char* Qs, char* Ks, char* KdT, const int ofs, const int t, const int c16,
                                              const uint4 rq, const uint4 rk, const float b, const float kdsc) {
  const float eb = __expf(b);
  const float ei = __builtin_amdgcn_rcpf(eb);
  const float kd = ei * kdsc;
  const u32 qw[4] = {rq.x, rq.y, rq.z, rq.w};
  const u32 kw[4] = {rk.x, rk.y, rk.z, rk.w};
  u32 qo[4], ko[4];
  char* kcol = KdT + (c16 * 8) * 128 + (t & 7) * 2;
  const int tch = t >> 3;
#pragma unroll
  for (int i = 0; i < 4; ++i) {
    const float q0 = bflo(qw[i]), q1 = bfhi(qw[i]), k0 = bflo(kw[i]), k1 = bfhi(kw[i]);
    qo[i] = pack2(q0 * eb, q1 * eb);
    ko[i] = pack2(k0 * ei, k1 * ei);
    const u32 kdp = pack2(k0 * kd, k1 * kd);
    const int sw = ((tch ^ (((c16 & 1) << 2) | i)) << 4);
    *reinterpret_cast<u16*>(kcol + (2 * i) * 128 + sw) = (u16)(kdp & 0xffffu);
    *reinterpret_cast<u16*>(kcol + (2 * i + 1) * 128 + sw) = (u16)(kdp >> 16);
  }
  *reinterpret_cast<uint4*>(Qs + ofs) = make_uint4(qo[0], qo[1], qo[2], qo[3]);
  *reinterpret_cast<uint4*>(Ks + ofs) = make_uint4(ko[0], ko[1], ko[2], ko[3]);
}
__device__ __forceinline__ void stage_chunk(char* Qs, char* Ks, char* KdT, char* VT, char* LRb, const int tid, const uint4 rq0,
                                            const uint4 rq1, const uint4 rk0, const uint4 rk1, const uint4 rv0,
                                            const uint4 rv1, const uint4 rv2, const uint4 rv3, const uint4 rl,
                                            const bool ret, const int dir, const float ld) {
  const int tk = tid >> 3, c16 = tid & 7;
  const int ofs = tk * 128 + ((c16 ^ ((tk >> 1) & 7)) << 4);
  if (!ret) {
    *reinterpret_cast<uint4*>(Qs + ofs) = rq0;
    *reinterpret_cast<uint4*>(Ks + ofs) = rk0;
    *reinterpret_cast<uint4*>(Qs + ofs + 4096) = rq1;
    *reinterpret_cast<uint4*>(Ks + ofs + 4096) = rk1;
  } else {
    const float kdsc = __expf(64.f * ld);
    stage_ret_row(Qs, Ks, KdT, ofs, tk, c16, rq0, rk0, dir ? ld * (float)(64 - tk) : ld * (float)(tk + 1), kdsc);
    stage_ret_row(Qs, Ks, KdT, ofs + 4096, tk + 32, c16, rq1, rk1, dir ? ld * (float)(32 - tk) : ld * (float)(tk + 33), kdsc);
  }
  stage_v(VT, tid, rv0, rv1, tid >> 5);
  stage_v(VT, tid, rv2, rv3, (tid >> 5) + 8);
  (void)LRb; (void)rl;
}

__device__ __forceinline__ bool rec_is_heavy(int bid) { return bid < 128; }
__device__ __forceinline__ int rec_light_index(int bid) { return bid - 128; }

__device__ void rec_phase(const P& p, char* smem, const int item, unsigned* gate, const unsigned gate_target = 136u) {
  const int tid = opaque_tid(), lane = tid & 63, w = tid >> 6, l15 = lane & 15, quad = lane >> 4;
  const int sx = (l15 >> 1) & 7;
  char* Qs = smem;
  char* Ks = smem + 8192;
  char* KdT = smem + 16384;
  char* VT = smem + 24576;
  char* SC = smem + 40960;
  char* ST = smem + 49152;
  char* LRb = smem + 65536;
  float* TOT = (float*)(smem + 69632);
  float* DEC = (float*)(smem + 70656);

  if (gate != nullptr) {
    if (tid == 0) {
      unsigned sp = 0;
      while (xb_ld(gate) < gate_target) { __builtin_amdgcn_s_sleep(4); if (++sp > (1u << 22)) break; }
      __builtin_amdgcn_fence(__ATOMIC_ACQUIRE, "agent");
      asm volatile("s_waitcnt vmcnt(0)" ::: "memory");
    }
    __syncthreads();
  }
  for (int once_ = 0; once_ < 1; ++once_) {
    const int it = item;
    const bool sample = it < 128;
    const int id = sample ? it : it - 128;
    const int dir = id & 1, hg = (id >> 1) & 7, b = id >> 4;
    const int row0 = sample ? NCTX + b * 2048 : b * 256;
    const int nch = sample ? 32 : 4;
    const bool gla = hg >= 4;
    const int hh = hg & 3;
    const int qcol = gla ? 1536 + hh * 64 : hh * 64;
    const int kcol = gla ? 1792 + hh * 64 : 256 + hh * 64;
    const int vcol = gla ? 2048 + hh * 128 : 512 + hh * 128;
    const int lrcol = 3072 + dir * 16;
    u16* obuf = dir ? p.ob : p.of;

    bf16x8 wafr[4];
    float bav[4];
    float ld = 0.f;
#pragma unroll
    for (int dt = 0; dt < 4; ++dt) {
      wafr[dt] = (bf16x8){0, 0, 0, 0, 0, 0, 0, 0};
      bav[dt] = 0.f;
    }
    if (gla) {
      int lo2_ = hh * 64 + l15;
      asm volatile("" : "+v"(lo2_));
      const uint4* wt_ = p.watab + ((dir * 4 + hh) * 4) * 64 + lane;
#pragma unroll
      for (int dt = 0; dt < 4; ++dt) {
        bav[dt] = p.gla_ba[dir * 256 + lo2_ + dt * 16];
        uint4 wv = wt_[dt * 64];
        wafr[dt] = *reinterpret_cast<bf16x8*>(&wv);
      }
    } else {
      ld = p.ret_ld[dir * 4 + hh];
    }

    f32x4 S[4][2];
    if (sample) {
      int lo_ = quad * 512 + 32 * w + l15;
      asm volatile("" : "+v"(lo_));
      const float* sp = (gla ? p.state_gla : p.state_ret) + (size_t)((b * 2 + dir) * 4 + hh) * 8192 + lo_;
#pragma unroll
      for (int dt = 0; dt < 4; ++dt)
#pragma unroll
        for (int et = 0; et < 2; ++et)
#pragma unroll
          for (int jj = 0; jj < 4; ++jj)
            S[dt][et][jj] = sp[dt * 2048 + jj * 128 + et * 16];
    } else {
#pragma unroll
      for (int dt = 0; dt < 4; ++dt)
#pragma unroll
        for (int et = 0; et < 2; ++et) S[dt][et] = (f32x4){0.f, 0.f, 0.f, 0.f};
    }
#pragma unroll
    for (int dt = 0; dt < 4; ++dt)
#pragma unroll
      for (int et = 0; et < 2; ++et) {
        int e = 32 * w + et * 16 + l15, d0 = dt * 16 + quad * 4;
        uint2 o;
        o.x = pack2(S[dt][et][0], S[dt][et][1]);
        o.y = pack2(S[dt][et][2], S[dt][et][3]);
        *reinterpret_cast<uint2*>(ST + e * 128 + (((d0 >> 3) ^ sx) << 4) + (d0 & 7) * 2) = o;
      }

    uint4 rq0, rq1, rk0, rk1, rv0, rv1, rv2, rv3, rl;
    rl = make_uint4(0, 0, 0, 0);
    int c = dir ? nch - 1 : 0;
    const int cstep = dir ? -1 : 1;
    const u16* pq0 = p.proj + (size_t)(row0 + (tid >> 3)) * NPROJ + (tid & 7) * 8;
    const u16* pv0 = p.proj + (size_t)(row0 + 2 * (tid & 31)) * NPROJ + vcol + (tid >> 5) * 8;
    const u16* pl0 = p.proj + (size_t)(row0 + 16 * w + l15) * NPROJ + lrcol + (quad & 1) * 8;
#define PREFETCH(cc)                                                            \
  {                                                                             \
    const size_t co_ = (size_t)(cc) * 64 * NPROJ;                               \
    rq0 = *reinterpret_cast<const uint4*>(pq0 + co_ + qcol);                    \
    rk0 = *reinterpret_cast<const uint4*>(pq0 + co_ + kcol);                    \
    rq1 = *reinterpret_cast<const uint4*>(pq0 + co_ + 32 * NPROJ + qcol);       \
    rk1 = *reinterpret_cast<const uint4*>(pq0 + co_ + 32 * NPROJ + kcol);       \
    rv0 = *reinterpret_cast<const uint4*>(pv0 + co_);                           \
    rv1 = *reinterpret_cast<const uint4*>(pv0 + co_ + NPROJ);                   \
    rv2 = *reinterpret_cast<const uint4*>(pv0 + co_ + 64);                      \
    rv3 = *reinterpret_cast<const uint4*>(pv0 + co_ + 64 + NPROJ);              \
    rl = *reinterpret_cast<const uint4*>(pl0 + co_);                            \
  }
    float gv[4][4];
    float Eq[4];
    if (!gla && tid < 64) DEC[tid] = __expf(64.f * ld);
    PREFETCH(c);
    stage_chunk(Qs, Ks, KdT, VT, LRb, tid, rq0, rq1, rk0, rk1, rv0, rv1, rv2, rv3, rl, !gla, dir, ld);
    {
        if (gla) {
          bf16x8 afr = (bf16x8){0, 0, 0, 0, 0, 0, 0, 0};
          if (quad < 2) afr = *reinterpret_cast<const bf16x8*>(&rl);
#pragma unroll
          for (int dt = 0; dt < 4; ++dt) {
            f32x4 z = MFMA(afr, wafr[dt], ((f32x4){0.f, 0.f, 0.f, 0.f}));
#pragma unroll
            for (int j = 0; j < 4; ++j) {
              float zz = z[j] + bav[dt];
              gv[dt][j] = (fminf(zz, 0.f) - __logf(1.f + __expf(-fabsf(zz)))) * (1.f / 16.f);
            }
          }
#pragma unroll
          for (int dt = 0; dt < 4; ++dt) {
            gv[dt][1] += gv[dt][0];
            gv[dt][2] += gv[dt][1];
            gv[dt][3] += gv[dt][2];
            const float T = gv[dt][3];
            const float x1 = __shfl_up(T, 16, 64), x2 = __shfl_up(T, 32, 64), x3 = __shfl_up(T, 48, 64);
            const float E = (quad >= 1 ? x1 : 0.f) + (quad >= 2 ? x2 : 0.f) + (quad >= 3 ? x3 : 0.f);
            Eq[dt] = E;
            const float Wt = __shfl(E + T, 48 + l15, 64);
            if (quad == 0) TOT[w * 64 + dt * 16 + l15] = Wt;
          }
        } else {
#pragma unroll
          for (int dt = 0; dt < 4; ++dt) {
#pragma unroll
            for (int j = 0; j < 4; ++j) gv[dt][j] = ld * (float)(j + 1);
            Eq[dt] = ld * (float)(4 * quad);
          }
        }
    }
    __syncthreads();
    for (int s = 0; s < nch; ++s, c += cstep) {
      const int rb = row0 + c * 64;
      {
        const int cn_ = (s + 1 < nch) ? (c + cstep) : c;
        PREFETCH(cn_);
      }
      if (gla) {
      {
        int qofs = (16 * w + quad * 4) * 128 + (l15 & 7) * 2;
        asm volatile("" : "+v"(qofs));
        float ebs[4], eis[4], ebt = 1.f;
#pragma unroll
        for (int dt = 0; dt < 4; ++dt) {
          const int d = dt * 16 + l15;
          if (gla || dt == 0) {
            float btot, off;
            if (gla) {
              const float t0 = TOT[d], t1 = TOT[64 + d], t2 = TOT[128 + d], t3 = TOT[192 + d];
              btot = t0 + t1 + t2 + t3;
              off = (w > 0 ? t0 : 0.f) + (w > 1 ? t1 : 0.f) + (w > 2 ? t2 : 0.f);
            } else {
              btot = 64.f * ld;
              off = ld * (float)(16 * w);
            }
            ebt = __expf(btot);
            const float base = off + Eq[dt];
#pragma unroll
            for (int j = 0; j < 4; ++j) {
              const float exj = (j == 0) ? 0.f : gv[dt][j - 1];
              const float bb = dir ? (btot - base - exj) : (base + gv[dt][j]);
              ebs[j] = __expf(bb);
              eis[j] = __builtin_amdgcn_rcpf(ebs[j]);
            }
          }
          if (w == 0 && quad == 0) DEC[d] = ebt;
          float kdv[4];
#pragma unroll
          for (int j = 0; j < 4; ++j) {
            const float eb = ebs[j];
            const float ei = eis[j];
            const int ofs = qofs + j * 128 + (((dt * 2 + (l15 >> 3)) ^ (quad * 2 + (j >> 1))) << 4);
            const float q = __uint_as_float((u32)(*reinterpret_cast<const u16*>(Qs + ofs)) << 16);
            const float k = __uint_as_float((u32)(*reinterpret_cast<const u16*>(Ks + ofs)) << 16);
            const float ki = k * ei;
            const u32 pk = pack2(q * eb, ki);
            *reinterpret_cast<u16*>(Qs + ofs) = (u16)(pk & 0xffffu);
            *reinterpret_cast<u16*>(Ks + ofs) = (u16)(pk >> 16);
            kdv[j] = ki * ebt;
          }
          uint2 kd2;
          kd2.x = pack2(kdv[0], kdv[1]);
          kd2.y = pack2(kdv[2], kdv[3]);
          *reinterpret_cast<uint2*>(KdT + d * 128 + (((2 * w + (quad >> 1)) ^ ((d >> 1) & 7)) << 4) + (quad & 1) * 8) = kd2;
        }
      }
      __syncthreads();
      }
      {
        f32x4 sacc[4];
#pragma unroll
        for (int jt = 0; jt < 4; ++jt) sacc[jt] = (f32x4){0.f, 0.f, 0.f, 0.f};
        int irow = 16 * w + l15;
        asm volatile("" : "+v"(irow));
        const int sgn = dir ? -1 : 1;
#pragma unroll
        for (int kk = 0; kk < 2; ++kk) {
          bf16x8 bq = ldfrag(Qs, irow, kk * 4 + quad, sx);
#pragma unroll
          for (int jt = 0; jt < 4; ++jt) {
            bf16x8 ak = ldfrag(Ks, jt * 16 + l15, kk * 4 + quad, sx);
            sacc[jt] = MFMA(ak, bq, sacc[jt]);
          }
        }
#pragma unroll
        for (int jt = 0; jt < 4; ++jt) {
          const int j0 = jt * 16 + quad * 4;
          float v[4];
          const int rel_ = (jt - w) * sgn;
          if (rel_ < 0) {
#pragma unroll
            for (int jj = 0; jj < 4; ++jj) v[jj] = sacc[jt][jj];
          } else if (rel_ > 0) {
#pragma unroll
            for (int jj = 0; jj < 4; ++jj) v[jj] = 0.f;
          } else {
#pragma unroll
            for (int jj = 0; jj < 4; ++jj) {
              int j = j0 + jj;
              bool keep = (j - irow) * sgn <= 0;
              v[jj] = keep ? sacc[jt][jj] : 0.f;
            }
          }
          uint2 o;
          o.x = pack2(v[0], v[1]);
          o.y = pack2(v[2], v[3]);
          *reinterpret_cast<uint2*>(SC + irow * 128 + (((j0 >> 3) ^ sx) << 4) + (j0 & 7) * 2) = o;
        }
      }
      __syncthreads();
      {
        f32x4 o[2][4];
#pragma unroll
        for (int et = 0; et < 2; ++et)
#pragma unroll
          for (int i4 = 0; i4 < 4; ++i4) o[et][i4] = (f32x4){0.f, 0.f, 0.f, 0.f};
        bf16x8 vt[2][2];
#pragma unroll
        for (int et = 0; et < 2; ++et)
#pragma unroll
          for (int kk = 0; kk < 2; ++kk) vt[et][kk] = ldfrag(VT, 32 * w + et * 16 + l15, kk * 4 + quad, sx);
#pragma unroll
        for (int kk = 0; kk < 2; ++kk)
#pragma unroll
          for (int i4 = 0; i4 < 4; ++i4) {
            bf16x8 scf = ldfrag(SC, i4 * 16 + l15, kk * 4 + quad, sx);
#pragma unroll
            for (int et = 0; et < 2; ++et) o[et][i4] = MFMA(vt[et][kk], scf, o[et][i4]);
          }
        asm volatile("" ::: "memory");
#pragma unroll
        for (int kk = 0; kk < 2; ++kk) {
          bf16x8 stf[2];
#pragma unroll
          for (int et = 0; et < 2; ++et) stf[et] = ldfrag(ST, 32 * w + et * 16 + l15, kk * 4 + quad, sx);
#pragma unroll
          for (int i4 = 0; i4 < 4; ++i4) {
            bf16x8 qf = ldfrag(Qs, i4 * 16 + l15, kk * 4 + quad, sx);
#pragma unroll
            for (int et = 0; et < 2; ++et) o[et][i4] = MFMA(stf[et], qf, o[et][i4]);
          }
          asm volatile("" ::: "memory");
        }
#pragma unroll
        for (int et = 0; et < 2; ++et)
#pragma unroll
          for (int i4 = 0; i4 < 4; ++i4) {
            int e0 = 32 * w + et * 16 + quad * 4;
            int i = i4 * 16 + l15;
            uint2 ov;
            ov.x = pack2(o[et][i4][0], o[et][i4][1]);
            ov.y = pack2(o[et][i4][2], o[et][i4][3]);
            *reinterpret_cast<uint2*>(obuf + (size_t)(rb + i) * 1024 + hg * 128 + e0) = ov;
          }
        asm volatile("" ::: "memory");
#pragma unroll
        for (int dt = 0; dt < 4; ++dt) {
          f32x4 dc = *reinterpret_cast<const f32x4*>(DEC + dt * 16 + quad * 4);
#pragma unroll
          for (int et = 0; et < 2; ++et) S[dt][et] *= dc;
        }
#pragma unroll
        for (int kk = 0; kk < 2; ++kk)
#pragma unroll
          for (int dt = 0; dt < 4; ++dt) {
            bf16x8 kf = ldfrag(KdT, dt * 16 + l15, kk * 4 + quad, sx);
#pragma unroll
            for (int et = 0; et < 2; ++et) S[dt][et] = MFMA(kf, vt[et][kk], S[dt][et]);
          }
#pragma unroll
        for (int dt = 0; dt < 4; ++dt)
#pragma unroll
          for (int et = 0; et < 2; ++et) {
            int e = 32 * w + et * 16 + l15, d0 = dt * 16 + quad * 4;
            uint2 ov;
            ov.x = pack2(S[dt][et][0], S[dt][et][1]);
            ov.y = pack2(S[dt][et][2], S[dt][et][3]);
            *reinterpret_cast<uint2*>(ST + e * 128 + (((d0 >> 3) ^ sx) << 4) + (d0 & 7) * 2) = ov;
          }
      }
      __syncthreads();
      stage_chunk(Qs, Ks, KdT, VT, LRb, tid, rq0, rq1, rk0, rk1, rv0, rv1, rv2, rv3, rl, !gla, dir, ld);
      {
        if (gla) {
          bf16x8 afr = (bf16x8){0, 0, 0, 0, 0, 0, 0, 0};
          if (quad < 2) afr = *reinterpret_cast<const bf16x8*>(&rl);
#pragma unroll
          for (int dt = 0; dt < 4; ++dt) {
            f32x4 z = MFMA(afr, wafr[dt], ((f32x4){0.f, 0.f, 0.f, 0.f}));
#pragma unroll
            for (int j = 0; j < 4; ++j) {
              float zz = z[j] + bav[dt];
              gv[dt][j] = (fminf(zz, 0.f) - __logf(1.f + __expf(-fabsf(zz)))) * (1.f / 16.f);
            }
          }
#pragma unroll
          for (int dt = 0; dt < 4; ++dt) {
            gv[dt][1] += gv[dt][0];
            gv[dt][2] += gv[dt][1];
            gv[dt][3] += gv[dt][2];
            const float T = gv[dt][3];
            const float x1 = __shfl_up(T, 16, 64), x2 = __shfl_up(T, 32, 64), x3 = __shfl_up(T, 48, 64);
            const float E = (quad >= 1 ? x1 : 0.f) + (quad >= 2 ? x2 : 0.f) + (quad >= 3 ? x3 : 0.f);
            Eq[dt] = E;
            const float Wt = __shfl(E + T, 48 + l15, 64);
            if (quad == 0) TOT[w * 64 + dt * 16 + l15] = Wt;
          }
        } else {
#pragma unroll
          for (int dt = 0; dt < 4; ++dt) {
#pragma unroll
            for (int j = 0; j < 4; ++j) gv[dt][j] = ld * (float)(j + 1);
            Eq[dt] = ld * (float)(4 * quad);
          }
        }
      }
      __syncthreads();
    }
#undef PREFETCH
    if (!sample) {
      int lo_ = quad * 512 + 32 * w + l15;
      asm volatile("" : "+v"(lo_));
      float* dp = p.out + (gla ? OFF_SG : OFF_SR) + (size_t)((b * 2 + dir) * 4 + hh) * 8192 + lo_;
#pragma unroll
      for (int dt = 0; dt < 4; ++dt)
#pragma unroll
        for (int et = 0; et < 2; ++et)
#pragma unroll
          for (int jj = 0; jj < 4; ++jj)
            dp[dt * 2048 + jj * 128 + et * 16] = S[dt][et][jj];
    }
  }
}

__device__ void mix_phase(const P& p, int bid, int nb) {
  const int tid_ = opaque_tid();
  const int lane = tid_ & 63, wid = tid_ >> 6;
  const int col0 = lane * 16, hg = lane >> 3;
  const int nw = nb * 4;
  const int zoff = 1024 + (hg < 4 ? col0 : col0 + 1024);
  float gwv[16];
#pragma unroll
  for (int i = 0; i < 16; ++i) gwv[i] = (hg < 4) ? 1.f : p.gla_nw[(col0 & 127) + i];
  for (int r0 = bid * 4 + wid; r0 < NROWS / 2; r0 += nw) {
    uint4 f0[2], f1[2], b0[2], b1[2], z0[2], z1[2];
#pragma unroll
    for (int u = 0; u < 2; ++u) {
      const int row = r0 + u * (NROWS / 2);
      const uint4* pf = reinterpret_cast<const uint4*>(p.of + (size_t)row * 1024 + col0);
      const uint4* pb = reinterpret_cast<const uint4*>(p.ob + (size_t)row * 1024 + col0);
      const uint4* pz = reinterpret_cast<const uint4*>(p.proj + (size_t)row * NPROJ + zoff);
      f0[u] = pf[0]; f1[u] = pf[1]; b0[u] = pb[0]; b1[u] = pb[1]; z0[u] = pz[0]; z1[u] = pz[1];
    }
#pragma unroll
    for (int u = 0; u < 2; ++u) {
      const int row = r0 + u * (NROWS / 2);
      const u32 fw[8] = {f0[u].x, f0[u].y, f0[u].z, f0[u].w, f1[u].x, f1[u].y, f1[u].z, f1[u].w};
      const u32 bw[8] = {b0[u].x, b0[u].y, b0[u].z, b0[u].w, b1[u].x, b1[u].y, b1[u].z, b1[u].w};
      const u32 zw[8] = {z0[u].x, z0[u].y, z0[u].z, z0[u].w, z1[u].x, z1[u].y, z1[u].z, z1[u].w};
      float o[16];
      float s1 = 0.f;
#pragma unroll
      for (int i = 0; i < 8; ++i) {
        o[2 * i] = bflo(fw[i]) + bflo(bw[i]);
        o[2 * i + 1] = bfhi(fw[i]) + bfhi(bw[i]);
        s1 += o[2 * i] + o[2 * i + 1];
      }
      s1 += __shfl_xor(s1, 1, 64);
      s1 += __shfl_xor(s1, 2, 64);
      s1 += __shfl_xor(s1, 4, 64);
      const float mu = (hg < 4) ? s1 * (1.f / 128.f) : 0.f;
      float s2 = 0.f;
#pragma unroll
      for (int i = 0; i < 16; ++i) { float dlt = o[i] - mu; s2 += dlt * dlt; }
      s2 += __shfl_xor(s2, 1, 64);
      s2 += __shfl_xor(s2, 2, 64);
      s2 += __shfl_xor(s2, 4, 64);
      const float rs = rsqrtf(s2 * (1.f / 128.f) + EPS);
      u32 ow[8];
#pragma unroll
      for (int i = 0; i < 8; ++i) {
        float za = bflo(zw[i]), zb = bfhi(zw[i]);
        float ya = (o[2 * i] - mu) * rs * gwv[2 * i] * (za * __builtin_amdgcn_rcpf(1.f + __expf(-za)));
        float yb = (o[2 * i + 1] - mu) * rs * gwv[2 * i + 1] * (zb * __builtin_amdgcn_rcpf(1.f + __expf(-zb)));
        ow[i] = pack2(ya, yb);
      }
      uint4* po = reinterpret_cast<uint4*>(p.h + (size_t)row * 1024 + col0);
      po[0] = make_uint4(ow[0], ow[1], ow[2], ow[3]);
      po[1] = make_uint4(ow[4], ow[5], ow[6], ow[7]);
    }
  }
}

__device__ void final_phase(const P& p, int bid, int nb) {
  const int tid_ = opaque_tid();
  const int lane = tid_ & 63, wid = tid_ >> 6;
  const int nw = nb * 4;
  float4 fw[4];
#pragma unroll
  for (int i = 0; i < 4; ++i) fw[i] = reinterpret_cast<const float4*>(p.fnw)[lane + 64 * i];
  for (int r0 = bid * 4 + wid; r0 < NROWS / 2; r0 += nw) {
    float4 v[2][4];
#pragma unroll
    for (int u = 0; u < 2; ++u)
#pragma unroll
      for (int i = 0; i < 4; ++i)
        v[u][i] = reinterpret_cast<const float4*>(p.out + (size_t)(r0 + u * (NROWS / 2)) * 1024)[lane + 64 * i];
#pragma unroll
    for (int u = 0; u < 2; ++u) {
      float4* yr = reinterpret_cast<float4*>(p.out + (size_t)(r0 + u * (NROWS / 2)) * 1024);
      float ss = 0.f;
#pragma unroll
      for (int i = 0; i < 4; ++i)
        ss += v[u][i].x * v[u][i].x + v[u][i].y * v[u][i].y + v[u][i].z * v[u][i].z + v[u][i].w * v[u][i].w;
      ss = wave_sum(ss);
      const float r = rsqrtf(ss * (1.f / 1024.f) + EPS);
#pragma unroll
      for (int i = 0; i < 4; ++i)
        yr[lane + 64 * i] = make_float4(v[u][i].x * r * fw[i].x, v[u][i].y * r * fw[i].y, v[u][i].z * r * fw[i].z,
                                        v[u][i].w * r * fw[i].w);
    }
  }
}

template <int PH>
__device__ __forceinline__ void run_phase(const P& p, int bid, int nb, char* smem) {
  if (PH == 0) phase0(p, bid, nb, smem);
  if (PH == 1) phase1(p, bid, nb);
  if (PH == 2) gemm_phase<1>(p, bid & 7, bid >> 3, nb >> 3, smem, 0);
  if (PH == 3) rec_phase(p, smem, bid, nullptr);
  if (PH == 4) mix_phase(p, bid, nb);
  if (PH == 5) gemm_phase<2>(p, bid & 7, bid >> 3, nb >> 3, smem, 2);
  if (PH == 6) final_phase(p, bid, nb);
}

#if MULTI_LAUNCH
template <int PH>
__global__ void __launch_bounds__(256, 2) phase_kernel(P p) {
  extern __shared__ __attribute__((aligned(16))) char smem[];
  run_phase<PH>(p, blockIdx.x, gridDim.x, smem);
}
#else
__global__ void __launch_bounds__(256, 2) mega_kernel(P p) {
  extern __shared__ __attribute__((aligned(16))) char smem[];
  __shared__ uint4 xb_words;
  if (threadIdx.x == 0) xb_words = make_uint4(0u, 0u, 0u, 0u);
  __syncthreads();
  XcdBarrier xb = xcd_barrier_post(p.bar, (volatile LAS unsigned*)&xb_words);
  const int bid = blockIdx.x, nb = gridDim.x;
  run_phase<0>(p, bid, nb, smem);
  xcd_barrier(xb);
  run_phase<1>(p, bid, nb, smem);
  xcd_barrier(xb);
  {
    const bool heavy = rec_is_heavy(bid);
    const int g_ = bid & 7, l_ = bid >> 3;
    const bool hgla = (l_ >> 1) >= 4;
    unsigned* gq = p.bar + 3520 + g_ * 64;
    int* sWork = reinterpret_cast<int*>(smem + 71168);
    bool scanned = !heavy;
#pragma nounroll
    for (;;) {
      int kind = 0, tm = 4, mtx = 0, ntx = 0, item = 0, post = 0;
      unsigned* gate = nullptr;
      unsigned gtarget = 0u;
      __syncthreads();
      if (threadIdx.x == 0) {
        int go = 0;
        if (!scanned) go = (xb_ld(gq + 16) >= (hgla ? 144u : 272u)) ? 1 : 0;
        sWork[1] = go;
        sWork[0] = go ? 0 : (int)xb_add(gq + 16, 1u);
      }
      __syncthreads();
      const int go_ = __builtin_amdgcn_readfirstlane(sWork[1]);
      const int wk = __builtin_amdgcn_readfirstlane(sWork[0]);
      if (go_) {
        kind = 1; item = (g_ << 4) | l_; scanned = true;
        gate = hgla ? (gq + 32) : (gq + 36); gtarget = hgla ? 144u : 128u;
      } else if (wk >= 664) {
        if (scanned) break;
        continue;
      } else if (wk < 144) { const int j_ = wk >> 4; ntx = (j_ < 8) ? 12 + j_ : 24; mtx = 64 + 16 * g_ + (wk & 15); tm = 3; post = 32; }
      else if (wk < 272) { const int u_ = wk - 144; ntx = u_ >> 4; mtx = 64 + 16 * g_ + (u_ & 15); tm = 3; post = 36; }
      else if (wk < 408) { const int u_ = wk - 272, j_ = u_ >> 3; ntx = (j_ < 8) ? j_ : (j_ < 16 ? j_ + 4 : 24); mtx = 8 * g_ + (u_ & 7); tm = 3; post = 40; }
      else if (wk >= 456 && wk < 520) { kind = 1; const int r_ = wk - 456; item = 128 + (((4 * g_ + (r_ >> 4)) << 4) | (r_ & 15)); gate = gq + 40; gtarget = 136u; }
      else {
        const int v_ = (wk < 456) ? wk - 408 : wk - 520 + 48;
        if (v_ < 64) { const int j_ = v_ >> 3; ntx = (j_ < 4) ? 8 + j_ : 16 + j_; mtx = 8 * g_ + (v_ & 7); }
        else { const int u_ = v_ - 64, j_ = u_ >> 4; ntx = (j_ < 4) ? 8 + j_ : 16 + j_; mtx = 64 + 16 * g_ + (u_ & 15); }
      }
      if (kind == 0) gemm_phase<1>(p, g_, 0, 1, smem, tm, mtx, ntx);
      else rec_phase(p, smem, item, gate, gtarget);
      if (post) {
        asm volatile("s_waitcnt vmcnt(0)" ::: "memory");
        __syncthreads();
        if (threadIdx.x == 0) xb_add(gq + post, 1u);
      }
    }
  }
  xcd_barrier(xb);
  run_phase<4>(p, bid, nb, smem);
  xcd_barrier(xb);
  run_phase<5>(p, bid, nb, smem);
}
#endif

extern "C" void kernel_launch(void* const* d_in, const int* in_sizes, int n_in, void* d_out, int out_size,
                              void* d_ws, size_t ws_size, hipStream_t stream) {
  constexpr size_t WS_MOD = 0, WS_ROPE = 131072, WS_WTIN = 262144, WS_WTOUT = WS_WTIN + 6553600,
                   WS_H = WS_WTOUT + 2097152, WS_PROJ = WS_H + 50331648, WS_END = WS_PROJ + (size_t)NROWS * NPROJ * 2;
  if (ws_size < WS_END + 32768 || n_in != 15) { fprintf(stderr, "kernel_launch: bad ws/n_in\n"); return; }
  P p{};
  p.x_prompt = (const float*)d_in[0]; p.x_sample = (const float*)d_in[1]; p.c = (const float*)d_in[2];
  p.state_ret = (const float*)d_in[3]; p.state_gla = (const float*)d_in[4]; p.c_ctx = (const float*)d_in[5];
  p.w_mod = (const float*)d_in[6]; p.b_mod = (const float*)d_in[7]; p.w_in = (const float*)d_in[8];
  p.ret_ld = (const float*)d_in[9]; p.gla_wa = (const float*)d_in[10]; p.gla_ba = (const float*)d_in[11];
  p.gla_nw = (const float*)d_in[12]; p.w_out = (const float*)d_in[13]; p.fnw = (const float*)d_in[14];
  p.out = (float*)d_out;
  char* ws = (char*)d_ws;
  p.mod = (float*)(ws + WS_MOD); p.rope = (float*)(ws + WS_ROPE); p.bar = (unsigned*)(ws + 114688); p.rowss = (float*)(ws + 147456); p.mcnt = (unsigned*)(ws + 245760);
  p.wt_in = (u16*)(ws + WS_WTIN); p.wt_out = (u16*)(ws + WS_WTOUT);
  p.h = (u16*)(ws + WS_H); p.proj = (u16*)(ws + WS_PROJ); p.watab = (uint4*)(ws + WS_END);
  p.of = (u16*)d_out; p.ob = (u16*)d_out + (size_t)NROWS * 1024;
  (void)hipMemsetAsync(ws, 0, 262144, stream);
#if MULTI_LAUNCH
  static int inited = 0;
  if (!inited) {
    hipFuncSetAttribute((const void*)phase_kernel<0>, hipFuncAttributeMaxDynamicSharedMemorySize, LDS_BYTES);
    hipFuncSetAttribute((const void*)phase_kernel<1>, hipFuncAttributeMaxDynamicSharedMemorySize, LDS_BYTES);
    hipFuncSetAttribute((const void*)phase_kernel<2>, hipFuncAttributeMaxDynamicSharedMemorySize, LDS_BYTES);
    hipFuncSetAttribute((const void*)phase_kernel<3>, hipFuncAttributeMaxDynamicSharedMemorySize, LDS_BYTES);
    hipFuncSetAttribute((const void*)phase_kernel<4>, hipFuncAttributeMaxDynamicSharedMemorySize, LDS_BYTES);
    hipFuncSetAttribute((const void*)phase_kernel<5>, hipFuncAttributeMaxDynamicSharedMemorySize, LDS_BYTES);
    hipFuncSetAttribute((const void*)phase_kernel<6>, hipFuncAttributeMaxDynamicSharedMemorySize, LDS_BYTES);
    inited = 1;
  }
  const int G = 512;
  phase_kernel<0><<<G, 256, LDS_BYTES, stream>>>(p);
  phase_kernel<1><<<G, 256, LDS_BYTES, stream>>>(p);
  phase_kernel<2><<<G, 256, LDS_BYTES, stream>>>(p);
  phase_kernel<3><<<G, 256, LDS_BYTES, stream>>>(p);
  phase_kernel<4><<<G, 256, LDS_BYTES, stream>>>(p);
  phase_kernel<5><<<G, 256, LDS_BYTES, stream>>>(p);
  phase_kernel<6><<<G, 256, LDS_BYTES, stream>>>(p);
#else
  static int grid_blocks = 0;
  if (!grid_blocks) {
    int dev = 0, cus = 0, per_cu = 0;
    hipGetDevice(&dev);
    hipDeviceGetAttribute(&cus, hipDeviceAttributeMultiprocessorCount, dev);
    hipFuncSetAttribute((const void*)mega_kernel, hipFuncAttributeMaxDynamicSharedMemorySize, LDS_BYTES);
    hipOccupancyMaxActiveBlocksPerMultiprocessor(&per_cu, (const void*)mega_kernel, 256, LDS_BYTES);
    (void)per_cu;
    per_cu = 2;
    grid_blocks = cus * per_cu;
  }
  void* args[] = {&p};
  hipError_t e = hipLaunchCooperativeKernel((const void*)mega_kernel, dim3(grid_blocks), dim3(256), args, LDS_BYTES, stream);
  if (e != hipSuccess) fprintf(stderr, "cooperative launch failed: %s (grid %d)\n", hipGetErrorString(e), grid_blocks);
#endif
}
```

```cpp
#include <hip/hip_runtime.h>
#include <cstdio>

#ifndef MULTI_LAUNCH
#define MULTI_LAUNCH 0
#endif

typedef unsigned short u16;
typedef unsigned int u32;
using bf16x8 = __attribute__((ext_vector_type(8))) short;
using f32x4 = __attribute__((ext_vector_type(4))) float;

constexpr int NROWS = 24576;
constexpr int NCTX = 8192;
constexpr int NPROJ = 3104;
constexpr int LDS_BYTES = 73728;
constexpr size_t OFF_SR = (size_t)NROWS * 1024;
constexpr size_t OFF_SG = OFF_SR + 2097152;
constexpr float EPS = 1e-6f;

struct P {
  const float *x_prompt, *x_sample, *c, *state_ret, *state_gla, *c_ctx, *w_mod, *b_mod, *w_in, *ret_ld,
      *gla_wa, *gla_ba, *gla_nw, *w_out, *fnw;
  float* out;
  float* mod;
  float* rope;
  u16* wt_in;
  u16* wt_out;
  u16* h;
  u16* proj;
  u16* of;
  u16* ob;
  unsigned* bar;
  uint4* watab;
  float* rowss;
  unsigned* mcnt;
};

__device__ __forceinline__ u32 f2bf(float f) {
  u32 u = __float_as_uint(f);
  return (u + 0x7fffu + ((u >> 16) & 1u)) >> 16;
}
typedef __bf16 bf16x2_t __attribute__((ext_vector_type(2)));
typedef float f32x2_t __attribute__((ext_vector_type(2)));
__device__ __forceinline__ u32 pack2(float a, float b) {
  f32x2_t v = {a, b};
  bf16x2_t r = __builtin_convertvector(v, bf16x2_t);
  return *reinterpret_cast<u32*>(&r);
}
__device__ __forceinline__ float bflo(u32 w) { return __uint_as_float(w << 16); }
__device__ __forceinline__ float bfhi(u32 w) { return __uint_as_float(w & 0xffff0000u); }
__device__ __forceinline__ float wave_sum(float v) {
#pragma unroll
  for (int m = 32; m >= 1; m >>= 1) v += __shfl_xor(v, m, 64);
  return v;
}
__device__ __forceinline__ bf16x8 ldfrag(const char* base, int row, int c16, int sx) {
  return *reinterpret_cast<const bf16x8*>(base + row * 128 + ((c16 ^ sx) << 4));
}
__device__ __forceinline__ int opaque_tid() { int t = threadIdx.x; asm volatile("" : "+v"(t)); return t; }
#define MFMA(a, b, c) __builtin_amdgcn_mfma_f32_16x16x32_bf16(a, b, c, 0, 0, 0)

#define XB_TMO      128
#define XB_XCNT(j)  (256  + 64 * (j))
#define XB_XSUB(j)  (1280 + 64 * (j))
#define XB_XGEN(j)  (2304 + 64 * (j))
#define XB_TOP      3328
#define XB_TOPGEN   3392
#define XCD_BAR_WORDS 3456
#define XB_SPIN_CAP (1u << 18)
#define LAS __attribute__((address_space(3)))
__device__ __forceinline__ unsigned xb_ld(unsigned* p) { return __hip_atomic_load(p, __ATOMIC_RELAXED, __HIP_MEMORY_SCOPE_AGENT); }
__device__ __forceinline__ unsigned xb_add(unsigned* p, unsigned v) { return __hip_atomic_fetch_add(p, v, __ATOMIC_RELAXED, __HIP_MEMORY_SCOPE_AGENT); }
__device__ __forceinline__ unsigned xb_xcc_id() { return (unsigned)__builtin_amdgcn_s_getreg((3 << 11) | 20) & 0xFu; }
#define XB_SPIN(cond, bar) do { unsigned _sp = 0; while (cond) { __builtin_amdgcn_s_sleep(1); \
    if ((++_sp & 255u) == 0u) { if (xb_ld(&(bar)[XB_TMO])) break; if (_sp > XB_SPIN_CAP) { atomicAdd(&(bar)[XB_TMO], 1u); break; } } } } while (0)
struct XcdBarrier { unsigned* bar; unsigned x; volatile LAS unsigned* st; };
__device__ __forceinline__ XcdBarrier xcd_barrier_post(unsigned* bar, volatile LAS unsigned* st) {
  XcdBarrier b; b.bar = bar; b.x = xb_xcc_id(); b.st = st;
  if (threadIdx.x == 0) (void)xb_add(&bar[XB_XCNT(b.x)], 1u);
  return b;
}
__device__ __forceinline__ void xcd_barrier_complete(unsigned* bar, unsigned x, unsigned& nloc, unsigned& nx) {
  const unsigned G = gridDim.x * gridDim.y * gridDim.z;
  unsigned sum, cnt, mine, sp = 0u;
  for (;;) {
    sum = 0u; cnt = 0u; mine = 0u;
#pragma unroll
    for (unsigned j = 0; j < 16; ++j) { const unsigned c = xb_ld(&bar[XB_XCNT(j)]); sum += c; cnt += (c > 0u) ? 1u : 0u; mine = (j == x) ? c : mine; }
    if (sum == G) break;
    __builtin_amdgcn_s_sleep(1);
    if ((++sp & 255u) == 0u) { if (xb_ld(&bar[XB_TMO])) break; if (sp > XB_SPIN_CAP) { atomicAdd(&bar[XB_TMO], 1u); break; } }
  }
  nloc = mine > 0u ? mine : 1u; nx = cnt > 0u ? cnt : 1u;
}
__device__ __forceinline__ void xcd_barrier(const XcdBarrier& b) {
  asm volatile("s_waitcnt vmcnt(0)" ::: "memory");
  __syncthreads();
  if (threadIdx.x == 0) {
    unsigned* bar = b.bar;
    __builtin_amdgcn_s_waitcnt(0);
    const unsigned bx = xb_xcc_id();
    unsigned nloc = b.st[0], nx = b.st[1];
    if (nloc == 0u) { xcd_barrier_complete(bar, bx, nloc, nx); b.st[0] = nloc; b.st[1] = nx; }
    const unsigned old = xb_add(&bar[XB_XSUB(bx)], 1u);
    const unsigned gen = old / nloc;
    if (old + 1u == (gen + 1u) * nloc) {
      __builtin_amdgcn_fence(__ATOMIC_RELEASE, "agent");
      asm volatile("s_waitcnt vmcnt(0)" ::: "memory");
      const unsigned og = xb_add(&bar[XB_TOP], 1u);
      const unsigned tg = og / nx;
      if (og + 1u == (tg + 1u) * nx) xb_add(&bar[XB_TOPGEN], 1u);
      else XB_SPIN(xb_ld(&bar[XB_TOPGEN]) == tg, bar);
      __builtin_amdgcn_fence(__ATOMIC_ACQUIRE, "agent");
      xb_add(&bar[XB_XGEN(bx)], 1u);
      asm volatile("s_waitcnt vmcnt(0)" ::: "memory");
    } else {
      XB_SPIN(xb_ld(&bar[XB_XGEN(bx)]) == gen, bar);
      __builtin_amdgcn_fence(__ATOMIC_ACQUIRE, "agent");
      asm volatile("s_waitcnt vmcnt(0)" ::: "memory");
    }
  }
  __syncthreads();
}

__device__ __forceinline__ void group_barrier(unsigned* ctr, unsigned n) {
  asm volatile("s_waitcnt vmcnt(0)" ::: "memory");
  __syncthreads();
  if (threadIdx.x == 0) {
    __builtin_amdgcn_fence(__ATOMIC_RELEASE, "agent");
    asm volatile("s_waitcnt vmcnt(0)" ::: "memory");
    xb_add(ctr, 1u);
    unsigned sp = 0;
    while (xb_ld(ctr) < n) { __builtin_amdgcn_s_sleep(8); if (++sp > (1u << 20)) break; }
    __builtin_amdgcn_fence(__ATOMIC_ACQUIRE, "agent");
    asm volatile("s_waitcnt vmcnt(0)" ::: "memory");
  }
  __syncthreads();
}

__device__ __forceinline__ void transpose_tile(const float* __restrict__ src, u16* __restrict__ dst, const int N,
                                               const int kt, const int ntile, char* smem, const int lane, const int wid) {
  float* tile = (float*)smem;
  const int k0 = kt * 64, n0 = ntile * 64;
  float tv_[16];
#pragma unroll
  for (int i = 0; i < 16; ++i) {
    int n = n0 + lane;
    tv_[i] = (n < N) ? src[(size_t)(k0 + wid + 4 * i) * N + n] : 0.f;
  }
#pragma unroll
  for (int i = 0; i < 16; ++i) tile[(wid + 4 * i) * 65 + lane] = tv_[i];
  __syncthreads();
  for (int i = wid; i < 64; i += 4)
    dst[(size_t)(n0 + i) * 1024 + k0 + lane] = (u16)f2bf(tile[lane * 65 + i]);
  __syncthreads();
}

__device__ void phase0(const P& p, int bid, int nb, char* smem) {
  const int tid = opaque_tid(), lane = tid & 63, wid = tid >> 6;
  const int NIT = 384 + 800 + 256 + 2;
  for (int it = bid; it < NIT; it += nb) {
    if (it < 384) {
      const int cb = it % 48, kc = it / 48;
      float* s = (float*)smem;
      float* red = s + 9 * 128;
      for (int i = tid; i < 9 * 128; i += 256) {
        int ci = i >> 7, kk = i & 127;
        int k = kc * 128 + kk;
        float v = (ci == 0) ? p.c_ctx[k] : p.c[(ci - 1) * 1024 + k];
        s[i] = v / (1.f + __expf(-v));
      }
      __syncthreads();
      float acc[9];
#pragma unroll
      for (int ci = 0; ci < 9; ++ci) acc[ci] = 0.f;
      const int col = cb * 64 + lane;
      const float* wp = p.w_mod + (size_t)(kc * 128 + wid * 32) * 3072 + col;
      float wv_[32];
#pragma unroll
      for (int kk = 0; kk < 32; ++kk) wv_[kk] = wp[(size_t)kk * 3072];
#pragma unroll
      for (int kk = 0; kk < 32; ++kk) {
        float w = wv_[kk];
#pragma unroll
        for (int ci = 0; ci < 9; ++ci) acc[ci] += s[ci * 128 + wid * 32 + kk] * w;
      }
#pragma unroll
      for (int ci = 0; ci < 9; ++ci) red[(wid * 9 + ci) * 64 + lane] = acc[ci];
      __syncthreads();
      for (int i = tid; i < 9 * 64; i += 256) {
        int ci = i >> 6, l = i & 63;
        float v = red[(0 * 9 + ci) * 64 + l] + red[(1 * 9 + ci) * 64 + l] + red[(2 * 9 + ci) * 64 + l] +
                  red[(3 * 9 + ci) * 64 + l];
        if (kc == 0) v += p.b_mod[cb * 64 + l];
        atomicAdd(&p.mod[ci * 3072 + cb * 64 + l], v);
      }
      __syncthreads();
    } else if (it < 384 + 800) {
      const int j = it - 384;
      transpose_tile(p.w_in, p.wt_in, NPROJ, j / 50, j % 50, smem, lane, wid);
    } else if (it < 384 + 800 + 256) {
      const int j = it - 384 - 800;
      transpose_tile(p.w_out, p.wt_out, 1024, j >> 4, j & 15, smem, lane, wid);
    } else if (it == 384 + 800 + 256 + 1) {
      for (int i = tid; i < 2048; i += 256) {
        const int ln = i & 63, dt = (i >> 6) & 3, hh = (i >> 8) & 3, dir = i >> 10;
        const int l15_ = ln & 15, quad_ = ln >> 4;
        uint4 wv = make_uint4(0u, 0u, 0u, 0u);
        if (quad_ < 2) {
          const float* wp_ = p.gla_wa + (size_t)(dir * 16 + quad_ * 8) * 256 + hh * 64 + dt * 16 + l15_;
          wv = make_uint4(pack2(wp_[0], wp_[256]), pack2(wp_[512], wp_[768]), pack2(wp_[1024], wp_[1280]), pack2(wp_[1536], wp_[1792]));
        }
        p.watab[i] = wv;
      }
    } else {
      for (int i = tid; i < 1024; i += 256) {
        int pos = i >> 4, f = i & 15;
        float inv = powf(10000.f, -(float)f / 16.f);
        float ang = (float)pos * inv;
        p.rope[i] = cosf(ang);
        p.rope[1024 + i] = sinf(ang);
      }
    }
  }
}

__device__ void phase1(const P& p, int bid, int nb) {
  const int tid_ = opaque_tid();
  const int lane = tid_ & 63, wid = tid_ >> 6;
  const int nw = nb * 4;
  for (int r0 = bid * 4 + wid; r0 < NROWS / 2; r0 += nw) {
    const float* xr[2];
    int ci[2];
#pragma unroll
    for (int u = 0; u < 2; ++u) {
      const int row = r0 + u * (NROWS / 2);
      if (row < NCTX) { xr[u] = p.x_prompt + (size_t)row * 1024; ci[u] = 0; }
      else { xr[u] = p.x_sample + (size_t)(row - NCTX) * 1024; ci[u] = 1 + ((row - NCTX) >> 11); }
    }
    float4 v[2][4];
#pragma unroll
    for (int u = 0; u < 2; ++u)
#pragma unroll
      for (int i = 0; i < 4; ++i) v[u][i] = reinterpret_cast<const float4*>(xr[u])[lane + 64 * i];
    float4 shv[2][4], scv[2][4];
#pragma unroll
    for (int u = 0; u < 2; ++u)
#pragma unroll
      for (int i = 0; i < 4; ++i) {
        const float* md_ = p.mod + ci[u] * 3072 + (lane + 64 * i) * 4;
        shv[u][i] = *reinterpret_cast<const float4*>(md_);
        scv[u][i] = *reinterpret_cast<const float4*>(md_ + 1024);
      }
    __builtin_amdgcn_sched_barrier(0);
#pragma unroll
    for (int u = 0; u < 2; ++u) {
      const int row = r0 + u * (NROWS / 2);
      float ss = 0.f;
#pragma unroll
      for (int i = 0; i < 4; ++i)
        ss += v[u][i].x * v[u][i].x + v[u][i].y * v[u][i].y + v[u][i].z * v[u][i].z + v[u][i].w * v[u][i].w;
      ss = wave_sum(ss);
      const float r = rsqrtf(ss * (1.f / 1024.f) + EPS);
#pragma unroll
      for (int i = 0; i < 4; ++i) {
        int col = (lane + 64 * i) * 4;
        const float4 sh = shv[u][i];
        const float4 sc = scv[u][i];
        uint2 o;
        o.x = pack2(v[u][i].x * r * (1.f + sc.x) + sh.x, v[u][i].y * r * (1.f + sc.y) + sh.y);
        o.y = pack2(v[u][i].z * r * (1.f + sc.z) + sh.z, v[u][i].w * r * (1.f + sc.w) + sh.w);
        *reinterpret_cast<uint2*>(p.h + (size_t)row * 1024 + col) = o;
      }
    }
  }
}

template <int MODE>
__device__ void gemm_phase(const P& p, const int xcd, const int local, const int nlocal, char* smem, const int tmode,
                           const int mt_x = 0, const int nt_x = 0) {
  constexpr int NT = (MODE == 1) ? 25 : 8;
  const u16* A = p.h;
  const u16* B = (MODE == 1) ? p.wt_in : p.wt_out;
  const int tid = opaque_tid(), lane = tid & 63, wid = tid >> 6, wr = wid >> 1, wc = wid & 1;
  const int l15 = lane & 15, quad = lane >> 4, sx = (l15 >> 1) & 7;
  const int lrow = tid >> 3, lc16 = tid & 7;
  const int wofs = lrow * 128 + ((lc16 ^ ((lrow >> 1) & 7)) << 4);
  const int ntiles = (tmode == 0) ? 320 : (tmode == 1 ? 280 : (tmode == 2 ? 192 : local + 1));
  for (int t = local; t < ntiles; t += nlocal) {
    int nt, mt;
    if (tmode == 0) {
      const int mg = t / 160, r_ = t % 160, j_ = r_ >> 3;
      nt = (j_ < 8) ? j_ : (j_ < 16 ? j_ + 4 : j_ + 5);
      mt = 64 + xcd * 16 + mg * 8 + (r_ & 7);
    } else if (tmode == 1) {
      if (t < 200) { nt = t >> 3; mt = xcd * 8 + (t & 7); }
      else { const int u_ = t - 200, mg = u_ / 40, r_ = u_ % 40, j_ = r_ >> 3; nt = (j_ < 4) ? 8 + j_ : 20; mt = 64 + xcd * 16 + mg * 8 + (r_ & 7); }
    } else if (tmode == 2) {
      const int mg = t >> 6, r_ = t & 63;
      nt = r_ >> 3; mt = xcd * 24 + mg * 8 + (r_ & 7);
    } else {
      nt = nt_x; mt = mt_x;
    }
    const int m0 = mt * 128, n0 = nt * 128;
    f32x4 acc[4][4];
#pragma unroll
    for (int a = 0; a < 4; ++a)
#pragma unroll
      for (int b = 0; b < 4; ++b) acc[a][b] = (f32x4){0.f, 0.f, 0.f, 0.f};
    const u16* ag = A + (size_t)(m0 + lrow) * 1024 + lc16 * 8;
    const u16* bg = B + (size_t)(n0 + lrow) * 1024 + lc16 * 8;
    uint4 ra0, ra1, ra2, ra3, rb0, rb1, rb2, rb3;
    uint4 sa0, sa1, sa2, sa3, sb0, sb1, sb2, sb3;
#define GLOAD(R, S, ksv)                                                              \
  {                                                                                   \
    const u16* a_ = ag + (ksv) * 64;                                                  \
    const u16* b_ = bg + (ksv) * 64;                                                  \
    R##0 = *reinterpret_cast<const uint4*>(a_);                                       \
    R##1 = *reinterpret_cast<const uint4*>(a_ + 32 * 1024);                           \
    R##2 = *reinterpret_cast<const uint4*>(a_ + 64 * 1024);                           \
    R##3 = *reinterpret_cast<const uint4*>(a_ + 96 * 1024);                           \
    S##0 = *reinterpret_cast<const uint4*>(b_);                                       \
    S##1 = *reinterpret_cast<const uint4*>(b_ + 32 * 1024);                           \
    S##2 = *reinterpret_cast<const uint4*>(b_ + 64 * 1024);                           \
    S##3 = *reinterpret_cast<const uint4*>(b_ + 96 * 1024);                           \
  }
#define LWRITE(buf, R, S)                                                             \
  {                                                                                   \
    char* d_ = smem + (buf) * 32768 + wofs;                                           \
    *reinterpret_cast<uint4*>(d_) = R##0;                                             \
    *reinterpret_cast<uint4*>(d_ + 4096) = R##1;                                      \
    *reinterpret_cast<uint4*>(d_ + 8192) = R##2;                                      \
    *reinterpret_cast<uint4*>(d_ + 12288) = R##3;                                     \
    *reinterpret_cast<uint4*>(d_ + 16384) = S##0;                                     \
    *reinterpret_cast<uint4*>(d_ + 16384 + 4096) = S##1;                              \
    *reinterpret_cast<uint4*>(d_ + 16384 + 8192) = S##2;                              \
    *reinterpret_cast<uint4*>(d_ + 16384 + 12288) = S##3;                             \
  }
#define COMPUTE(buf)                                                                  \
  {                                                                                   \
    const char* cur = smem + (buf) * 32768;                                           \
    _Pragma("unroll") for (int kk = 0; kk < 2; ++kk) {                                \
      bf16x8 af[4], bfr[4];                                                           \
      _Pragma("unroll") for (int ns = 0; ns < 4; ++ns)                                \
          af[ns] = ldfrag(cur + 16384, wc * 64 + ns * 16 + l15, kk * 4 + quad, sx);   \
      _Pragma("unroll") for (int ms = 0; ms < 4; ++ms)                                \
          bfr[ms] = ldfrag(cur, wr * 64 + ms * 16 + l15, kk * 4 + quad, sx);          \
      _Pragma("unroll") for (int ns = 0; ns < 4; ++ns)                                \
          _Pragma("unroll") for (int ms = 0; ms < 4; ++ms)                            \
              acc[ns][ms] = MFMA(af[ns], bfr[ms], acc[ns][ms]);                       \
    }                                                                                 \
  }
    f32x4 xpre[4][4];
    GLOAD(ra, rb, 0);
    GLOAD(sa, sb, 1);
    LWRITE(0, ra, rb);
    __syncthreads();
#pragma unroll
    for (int ks = 0; ks < 16; ks += 2) {
      if (ks + 2 < 16) GLOAD(ra, rb, ks + 2);
      if (MODE == 2 && ks == 14) {
        const float* xb_ = (m0 < NCTX) ? p.x_prompt : (p.x_sample - (size_t)NCTX * 1024);
        const float* xp_ = xb_ + (size_t)(m0 + wr * 64 + l15) * 1024 + (n0 + wc * 64 + quad * 4);
#pragma unroll
        for (int ns = 0; ns < 4; ++ns)
#pragma unroll
          for (int ms = 0; ms < 4; ++ms) xpre[ns][ms] = *reinterpret_cast<const f32x4*>(xp_ + (size_t)ms * 16 * 1024 + ns * 16);
      }
      __builtin_amdgcn_sched_barrier(0);
      COMPUTE(0);
      LWRITE(1, sa, sb);
      __syncthreads();
      if (ks + 3 < 16) GLOAD(sa, sb, ks + 3);
      __builtin_amdgcn_sched_barrier(0);
      COMPUTE(1);
      if (ks + 2 < 16) LWRITE(0, ra, rb);
      __syncthreads();
    }
#undef GLOAD
#undef LWRITE
#undef COMPUTE
    const int colbase = n0 + wc * 64;
    if (MODE == 1) {
      if (colbase < NPROJ) {
        const bool sample = m0 >= NCTX;
        const bool scaled = (colbase >= 256 && colbase < 512) || (colbase >= 1536 && colbase < 1792);
        if (scaled) {
#pragma unroll
          for (int a = 0; a < 4; ++a)
#pragma unroll
            for (int b = 0; b < 4; ++b) acc[a][b] *= 0.125f;
        }
        if (sample && colbase < 512) {
#pragma unroll
          for (int ms = 0; ms < 4; ++ms) {
            int m = m0 + wr * 64 + ms * 16 + l15;
            int tkn = (m - NCTX) & 2047;
            int r = tkn >> 6, c = tkn & 63;
            f32x4 c0 = *reinterpret_cast<const f32x4*>(p.rope + r * 16 + quad * 4);
            f32x4 s0 = *reinterpret_cast<const f32x4*>(p.rope + 1024 + r * 16 + quad * 4);
            f32x4 c1 = *reinterpret_cast<const f32x4*>(p.rope + c * 16 + quad * 4);
            f32x4 s1 = *reinterpret_cast<const f32x4*>(p.rope + 1024 + c * 16 + quad * 4);
            f32x4 x1 = acc[0][ms], x2 = acc[2][ms];
            acc[0][ms] = x1 * c0 - x2 * s0;
            acc[2][ms] = x2 * c0 + x1 * s0;
            x1 = acc[1][ms]; x2 = acc[3][ms];
            acc[1][ms] = x1 * c1 - x2 * s1;
            acc[3][ms] = x2 * c1 + x1 * s1;
          }
        }
#pragma unroll
        for (int ns = 0; ns < 4; ++ns) {
          int n = colbase + ns * 16 + quad * 4;
          if (n < NPROJ) {
#pragma unroll
            for (int ms = 0; ms < 4; ++ms) {
              int m = m0 + wr * 64 + ms * 16 + l15;
              uint2 o;
              o.x = pack2(acc[ns][ms][0], acc[ns][ms][1]);
              o.y = pack2(acc[ns][ms][2], acc[ns][ms][3]);
              if (tmode == 3)
                __hip_atomic_store(reinterpret_cast<unsigned long long*>(p.proj + (size_t)m * NPROJ + n),
                                   ((unsigned long long)o.y << 32) | o.x, __ATOMIC_RELAXED, __HIP_MEMORY_SCOPE_AGENT);
              else
                *reinterpret_cast<uint2*>(p.proj + (size_t)m * NPROJ + n) = o;
            }
          }
        }
      }
    } else {
      const int ci = (m0 < NCTX) ? 0 : 1 + ((m0 - NCTX) >> 11);
      const float* gate = p.mod + ci * 3072 + 2048;
#pragma unroll
      for (int ns = 0; ns < 4; ++ns) {
        int n = colbase + ns * 16 + quad * 4;
        f32x4 g = *reinterpret_cast<const f32x4*>(gate + n);
#pragma unroll
        for (int ms = 0; ms < 4; ++ms) {
          acc[ns][ms] = xpre[ns][ms] + g * acc[ns][ms];
        }
      }
#pragma unroll
      for (int ms = 0; ms < 4; ++ms) {
        float ssq = 0.f;
#pragma unroll
        for (int ns = 0; ns < 4; ++ns)
#pragma unroll
          for (int j = 0; j < 4; ++j) ssq += acc[ns][ms][j] * acc[ns][ms][j];
        ssq += __shfl_xor(ssq, 16, 64);
        ssq += __shfl_xor(ssq, 32, 64);
        if (quad == 0)
          (void)__hip_atomic_fetch_add(p.rowss + m0 + wr * 64 + ms * 16 + l15, ssq, __ATOMIC_RELAXED, __HIP_MEMORY_SCOPE_AGENT);
      }
      asm volatile("s_waitcnt vmcnt(0)" ::: "memory");
      __syncthreads();
      if (tid == 0) {
        xb_add(p.mcnt + mt, 1u);
        unsigned sp = 0;
        while (xb_ld(p.mcnt + mt) < 8u) { __builtin_amdgcn_s_sleep(2); if (++sp > (1u << 22)) break; }
      }
      __syncthreads();
#pragma unroll
      for (int ms = 0; ms < 4; ++ms) {
        const int m = m0 + wr * 64 + ms * 16 + l15;
        const float ssr = __hip_atomic_load(p.rowss + m, __ATOMIC_RELAXED, __HIP_MEMORY_SCOPE_AGENT);
        const float rn = rsqrtf(ssr * (1.f / 1024.f) + EPS);
#pragma unroll
        for (int ns = 0; ns < 4; ++ns) {
          const int n = colbase + ns * 16 + quad * 4;
          const f32x4 fwv = *reinterpret_cast<const f32x4*>(p.fnw + n);
          *reinterpret_cast<f32x4*>(p.out + (size_t)m * 1024 + n) = acc[ns][ms] * rn * fwv;
        }
      }
    }
  }
}

__device__ __forceinline__ void stage_v(char* VT, const int tid, const uint4 RA, const uint4 RB, const int e8) {
  const int pp = tid & 31;
  const u32 a0[4] = {RA.x, RA.y, RA.z, RA.w};
  const u32 a1[4] = {RB.x, RB.y, RB.z, RB.w};
#pragma unroll
  for (int ei = 0; ei < 8; ++ei) {
    int e = e8 * 8 + ei;
    const u32 pk = __builtin_amdgcn_perm(a1[ei >> 1], a0[ei >> 1], (ei & 1) ? 0x07060302u : 0x05040100u);
    int ofs = e * 128 + (((pp >> 2) ^ ((e >> 1) & 7)) << 4) + (pp & 3) * 4;
    *reinterpret_cast<u32*>(VT + ofs) = pk;
  }
}
__device__ __forceinline__ void stage_ret_row(char* Qs, char* Ks, char* KdT, const int ofs, const int t, const int c16,
                                              const uint4 rq, const uint4 rk, const float b, const float kdsc) {
  const float eb = __expf(b);
  const float ei = __builtin_amdgcn_rcpf(eb);
  const float kd = ei * kdsc;
  const u32 qw[4] = {rq.x, rq.y, rq.z, rq.w};
  const u32 kw[4] = {rk.x, rk.y, rk.z, rk.w};
  u32 qo[4], ko[4];
  char* kcol = KdT + (c16 * 8) * 128 + (t & 7) * 2;
  const int tch = t >> 3;
#pragma unroll
  for (int i = 0; i < 4; ++i) {
    const float q0 = bflo(qw[i]), q1 = bfhi(qw[i]), k0 = bflo(kw[i]), k1 = bfhi(kw[i]);
    qo[i] = pack2(q0 * eb, q1 * eb);
    ko[i] = pack2(k0 * ei, k1 * ei);
    const u32 kdp = pack2(k0 * kd, k1 * kd);
    const int sw = ((tch ^ (((c16 & 1) << 2) | i)) << 4);
    *reinterpret_cast<u16*>(kcol + (2 * i) * 128 + sw) = (u16)(kdp & 0xffffu);
    *reinterpret_cast<u16*>(kcol + (2 * i + 1) * 128 + sw) = (u16)(kdp >> 16);
  }
  *reinterpret_cast<uint4*>(Qs + ofs) = make_uint4(qo[0], qo[1], qo[2], qo[3]);
  *reinterpret_cast<uint4*>(Ks + ofs) = make_uint4(ko[0], ko[1], ko[2], ko[3]);
}
__device__ __forceinline__ void stage_chunk(char* Qs, char* Ks, char* KdT, char* VT, char* LRb, const int tid, const uint4 rq0,
                                            const uint4 rq1, const uint4 rk0, const uint4 rk1, const uint4 rv0,
                                            const uint4 rv1, const uint4 rv2, const uint4 rv3, const uint4 rl,
                                            const bool ret, const int dir, const float ld) {
  const int tk = tid >> 3, c16 = tid & 7;
  const int ofs = tk * 128 + ((c16 ^ ((tk >> 1) & 7)) << 4);
  if (!ret) {
    *reinterpret_cast<uint4*>(Qs + ofs) = rq0;
    *reinterpret_cast<uint4*>(Ks + ofs) = rk0;
    *reinterpret_cast<uint4*>(Qs + ofs + 4096) = rq1;
    *reinterpret_cast<uint4*>(Ks + ofs + 4096) = rk1;
  } else {
    const float kdsc = __expf(64.f * ld);
    stage_ret_row(Qs, Ks, KdT, ofs, tk, c16, rq0, rk0, dir ? ld * (float)(64 - tk) : ld * (float)(tk + 1), kdsc);
    stage_ret_row(Qs, Ks, KdT, ofs + 4096, tk + 32, c16, rq1, rk1, dir ? ld * (float)(32 - tk) : ld * (float)(tk + 33), kdsc);
  }
  stage_v(VT, tid, rv0, rv1, tid >> 5);
  stage_v(VT, tid, rv2, rv3, (tid >> 5) + 8);
  (void)LRb; (void)rl;
}

__device__ __forceinline__ bool rec_is_heavy(int bid) { return bid < 128; }
__device__ __forceinline__ int rec_light_index(int bid) { return bid - 128; }

__device__ void rec_phase(const P& p, char* smem, const int item, unsigned* gate, const unsigned gate_target = 136u) {
  const int tid = opaque_tid(), lane = tid & 63, w = tid >> 6, l15 = lane & 15, quad = lane >> 4;
  const int sx = (l15 >> 1) & 7;
  char* Qs = smem;
  char* Ks = smem + 8192;
  char* KdT = smem + 16384;
  char* VT = smem + 24576;
  char* SC = smem + 40960;
  char* ST = smem + 49152;
  char* LRb = smem + 65536;
  float* TOT = (float*)(smem + 69632);
  float* DEC = (float*)(smem + 70656);

  for (int once_ = 0; once_ < 1; ++once_) {
    const int it = item;
    const bool sample = it < 128;
    const int id = sample ? it : it - 128;
    const int dir = id & 1, hg = (id >> 1) & 7, b = id >> 4;
    const int row0 = sample ? NCTX + b * 2048 : b * 256;
    const int nch = sample ? 32 : 4;
    const bool gla = hg >= 4;
    const int hh = hg & 3;
    const int qcol = gla ? 1536 + hh * 64 : hh * 64;
    const int kcol = gla ? 1792 + hh * 64 : 256 + hh * 64;
    const int vcol = gla ? 2048 + hh * 128 : 512 + hh * 128;
    const int lrcol = 3072 + dir * 16;
    u16* obuf = dir ? p.ob : p.of;

    bf16x8 wafr[4];
    float bav[4];
    float ld = 0.f;
#pragma unroll
    for (int dt = 0; dt < 4; ++dt) {
      wafr[dt] = (bf16x8){0, 0, 0, 0, 0, 0, 0, 0};
      bav[dt] = 0.f;
    }
    if (gla) {
      int lo2_ = hh * 64 + l15;
      asm volatile("" : "+v"(lo2_));
      const uint4* wt_ = p.watab + ((dir * 4 + hh) * 4) * 64 + lane;
#pragma unroll
      for (int dt = 0; dt < 4; ++dt) {
        bav[dt] = p.gla_ba[dir * 256 + lo2_ + dt * 16];
        uint4 wv = wt_[dt * 64];
        wafr[dt] = *reinterpret_cast<bf16x8*>(&wv);
      }
    } else {
      ld = p.ret_ld[dir * 4 + hh];
    }

    f32x4 S[4][2];
    if (sample) {
      int lo_ = quad * 512 + 32 * w + l15;
      asm volatile("" : "+v"(lo_));
      const float* sp = (gla ? p.state_gla : p.state_ret) + (size_t)((b * 2 + dir) * 4 + hh) * 8192 + lo_;
#pragma unroll
      for (int dt = 0; dt < 4; ++dt)
#pragma unroll
        for (int et = 0; et < 2; ++et)
#pragma unroll
          for (int jj = 0; jj < 4; ++jj)
            S[dt][et][jj] = sp[dt * 2048 + jj * 128 + et * 16];
    } else {
#pragma unroll
      for (int dt = 0; dt < 4; ++dt)
#pragma unroll
        for (int et = 0; et < 2; ++et) S[dt][et] = (f32x4){0.f, 0.f, 0.f, 0.f};
    }
#pragma unroll
    for (int dt = 0; dt < 4; ++dt)
#pragma unroll
      for (int et = 0; et < 2; ++et) {
        int e = 32 * w + et * 16 + l15, d0 = dt * 16 + quad * 4;
        uint2 o;
        o.x = pack2(S[dt][et][0], S[dt][et][1]);
        o.y = pack2(S[dt][et][2], S[dt][et][3]);
        *reinterpret_cast<uint2*>(ST + e * 128 + (((d0 >> 3) ^ sx) << 4) + (d0 & 7) * 2) = o;
      }

    uint4 rq0, rq1, rk0, rk1, rv0, rv1, rv2, rv3, rl;
    rl = make_uint4(0, 0, 0, 0);
    int c = dir ? nch - 1 : 0;
    const int cstep = dir ? -1 : 1;
    const u16* pq0 = p.proj + (size_t)(row0 + (tid >> 3)) * NPROJ + (tid & 7) * 8;
    const u16* pv0 = p.proj + (size_t)(row0 + 2 * (tid & 31)) * NPROJ + vcol + (tid >> 5) * 8;
    const u16* pl0 = p.proj + (size_t)(row0 + 16 * w + l15) * NPROJ + lrcol + (quad & 1) * 8;
#define PREFETCH(cc)                                                            \
  {                                                                             \
    const size_t co_ = (size_t)(cc) * 64 * NPROJ;                               \
    rq0 = *reinterpret_cast<const uint4*>(pq0 + co_ + qcol);                    \
    rk0 = *reinterpret_cast<const uint4*>(pq0 + co_ + kcol);                    \
    rq1 = *reinterpret_cast<const uint4*>(pq0 + co_ + 32 * NPROJ + qcol);       \
    rk1 = *reinterpret_cast<const uint4*>(pq0 + co_ + 32 * NPROJ + kcol);       \
    rv0 = *reinterpret_cast<const uint4*>(pv0 + co_);                           \
    rv1 = *reinterpret_cast<const uint4*>(pv0 + co_ + NPROJ);                   \
    rv2 = *reinterpret_cast<const uint4*>(pv0 + co_ + 64);                      \
    rv3 = *reinterpret_cast<const uint4*>(pv0 + co_ + 64 + NPROJ);              \
    rl = *reinterpret_cast<const uint4*>(pl0 + co_);                            \
  }
    float gv[4][4];
    float Eq[4];
    if (!gla && tid < 64) DEC[tid] = __expf(64.f * ld);
    if (gate != nullptr) {
      if (tid == 0) {
        unsigned sp = 0;
        while (xb_ld(gate) < gate_target) { __builtin_amdgcn_s_sleep(4); if (++sp > (1u << 22)) break; }
        __builtin_amdgcn_fence(__ATOMIC_ACQUIRE, "agent");
        asm volatile("s_waitcnt vmcnt(0)" ::: "memory");
      }
      __syncthreads();
    }
    PREFETCH(c);
    stage_chunk(Qs, Ks, KdT, VT, LRb, tid, rq0, rq1, rk0, rk1, rv0, rv1, rv2, rv3, rl, !gla, dir, ld);
    {
        if (gla) {
          bf16x8 afr = (bf16x8){0, 0, 0, 0, 0, 0, 0, 0};
          if (quad < 2) afr = *reinterpret_cast<const bf16x8*>(&rl);
#pragma unroll
          for (int dt = 0; dt < 4; ++dt) {
            f32x4 z = MFMA(afr, wafr[dt], ((f32x4){0.f, 0.f, 0.f, 0.f}));
#pragma unroll
            for (int j = 0; j < 4; ++j) {
              float zz = z[j] + bav[dt];
              gv[dt][j] = (fminf(zz, 0.f) - __logf(1.f + __expf(-fabsf(zz)))) * (1.f / 16.f);
            }
          }
#pragma unroll
          for (int dt = 0; dt < 4; ++dt) {
            gv[dt][1] += gv[dt][0];
            gv[dt][2] += gv[dt][1];
            gv[dt][3] += gv[dt][2];
            const float T = gv[dt][3];
            const float x1 = __shfl_up(T, 16, 64), x2 = __shfl_up(T, 32, 64), x3 = __shfl_up(T, 48, 64);
            const float E = (quad >= 1 ? x1 : 0.f) + (quad >= 2 ? x2 : 0.f) + (quad >= 3 ? x3 : 0.f);
            Eq[dt] = E;
            const float Wt = __shfl(E + T, 48 + l15, 64);
            if (quad == 0) TOT[w * 64 + dt * 16 + l15] = Wt;
          }
        } else {
#pragma unroll
          for (int dt = 0; dt < 4; ++dt) {
#pragma unroll
            for (int j = 0; j < 4; ++j) gv[dt][j] = ld * (float)(j + 1);
            Eq[dt] = ld * (float)(4 * quad);
          }
        }
    }
    __syncthreads();
    for (int s = 0; s < nch; ++s, c += cstep) {
      const int rb = row0 + c * 64;
      {
        const int cn_ = (s + 1 < nch) ? (c + cstep) : c;
        PREFETCH(cn_);
      }
      if (gla) {
      {
        int qofs = (16 * w + quad * 4) * 128 + (l15 & 7) * 2;
        asm volatile("" : "+v"(qofs));
        float ebs[4], eis[4], ebt = 1.f;
#pragma unroll
        for (int dt = 0; dt < 4; ++dt) {
          const int d = dt * 16 + l15;
          if (gla || dt == 0) {
            float btot, off;
            if (gla) {
              const float t0 = TOT[d], t1 = TOT[64 + d], t2 = TOT[128 + d], t3 = TOT[192 + d];
              btot = t0 + t1 + t2 + t3;
              off = (w > 0 ? t0 : 0.f) + (w > 1 ? t1 : 0.f) + (w > 2 ? t2 : 0.f);
            } else {
              btot = 64.f * ld;
              off = ld * (float)(16 * w);
            }
            ebt = __expf(btot);
            const float base = off + Eq[dt];
#pragma unroll
            for (int j = 0; j < 4; ++j) {
              const float exj = (j == 0) ? 0.f : gv[dt][j - 1];
              const float bb = dir ? (btot - base - exj) : (base + gv[dt][j]);
              ebs[j] = __expf(bb);
              eis[j] = __builtin_amdgcn_rcpf(ebs[j]);
            }
          }
          if (w == 0 && quad == 0) DEC[d] = ebt;
          float kdv[4];
#pragma unroll
          for (int j = 0; j < 4; ++j) {
            const float eb = ebs[j];
            const float ei = eis[j];
            const int ofs = qofs + j * 128 + (((dt * 2 + (l15 >> 3)) ^ (quad * 2 + (j >> 1))) << 4);
            const float q = __uint_as_float((u32)(*reinterpret_cast<const u16*>(Qs + ofs)) << 16);
            const float k = __uint_as_float((u32)(*reinterpret_cast<const u16*>(Ks + ofs)) << 16);
            const float ki = k * ei;
            const u32 pk = pack2(q * eb, ki);
            *reinterpret_cast<u16*>(Qs + ofs) = (u16)(pk & 0xffffu);
            *reinterpret_cast<u16*>(Ks + ofs) = (u16)(pk >> 16);
            kdv[j] = ki * ebt;
          }
          uint2 kd2;
          kd2.x = pack2(kdv[0], kdv[1]);
          kd2.y = pack2(kdv[2], kdv[3]);
          *reinterpret_cast<uint2*>(KdT + d * 128 + (((2 * w + (quad >> 1)) ^ ((d >> 1) & 7)) << 4) + (quad & 1) * 8) = kd2;
        }
      }
      __syncthreads();
      }
      {
        f32x4 sacc[4];
#pragma unroll
        for (int jt = 0; jt < 4; ++jt) sacc[jt] = (f32x4){0.f, 0.f, 0.f, 0.f};
        int irow = 16 * w + l15;
        asm volatile("" : "+v"(irow));
        const int sgn = dir ? -1 : 1;
#pragma unroll
        for (int kk = 0; kk < 2; ++kk) {
          bf16x8 bq = ldfrag(Qs, irow, kk * 4 + quad, sx);
#pragma unroll
          for (int jt = 0; jt < 4; ++jt) {
            bf16x8 ak = ldfrag(Ks, jt * 16 + l15, kk * 4 + quad, sx);
            sacc[jt] = MFMA(ak, bq, sacc[jt]);
          }
        }
#pragma unroll
        for (int jt = 0; jt < 4; ++jt) {
          const int j0 = jt * 16 + quad * 4;
          float v[4];
          const int rel_ = (jt - w) * sgn;
          if (rel_ < 0) {
#pragma unroll
            for (int jj = 0; jj < 4; ++jj) v[jj] = sacc[jt][jj];
          } else if (rel_ > 0) {
#pragma unroll
            for (int jj = 0; jj < 4; ++jj) v[jj] = 0.f;
          } else {
#pragma unroll
            for (int jj = 0; jj < 4; ++jj) {
              int j = j0 + jj;
              bool keep = (j - irow) * sgn <= 0;
              v[jj] = keep ? sacc[jt][jj] : 0.f;
            }
          }
          uint2 o;
          o.x = pack2(v[0], v[1]);
          o.y = pack2(v[2], v[3]);
          *reinterpret_cast<uint2*>(SC + irow * 128 + (((j0 >> 3) ^ sx) << 4) + (j0 & 7) * 2) = o;
        }
      }
      __syncthreads();
      {
        f32x4 o[2][4];
#pragma unroll
        for (int et = 0; et < 2; ++et)
#pragma unroll
          for (int i4 = 0; i4 < 4; ++i4) o[et][i4] = (f32x4){0.f, 0.f, 0.f, 0.f};
        bf16x8 vt[2][2];
#pragma unroll
        for (int et = 0; et < 2; ++et)
#pragma unroll
          for (int kk = 0; kk < 2; ++kk) vt[et][kk] = ldfrag(VT, 32 * w + et * 16 + l15, kk * 4 + quad, sx);
#pragma unroll
        for (int kk = 0; kk < 2; ++kk)
#pragma unroll
          for (int i4 = 0; i4 < 4; ++i4) {
            bf16x8 scf = ldfrag(SC, i4 * 16 + l15, kk * 4 + quad, sx);
#pragma unroll
            for (int et = 0; et < 2; ++et) o[et][i4] = MFMA(vt[et][kk], scf, o[et][i4]);
          }
        asm volatile("" ::: "memory");
#pragma unroll
        for (int kk = 0; kk < 2; ++kk) {
          bf16x8 stf[2];
#pragma unroll
          for (int et = 0; et < 2; ++et) stf[et] = ldfrag(ST, 32 * w + et * 16 + l15, kk * 4 + quad, sx);
#pragma unroll
          for (int i4 = 0; i4 < 4; ++i4) {
            bf16x8 qf = ldfrag(Qs, i4 * 16 + l15, kk * 4 + quad, sx);
#pragma unroll
            for (int et = 0; et < 2; ++et) o[et][i4] = MFMA(stf[et], qf, o[et][i4]);
          }
          asm volatile("" ::: "memory");
        }
#pragma unroll
        for (int et = 0; et < 2; ++et)
#pragma unroll
          for (int i4 = 0; i4 < 4; ++i4) {
            int e0 = 32 * w + et * 16 + quad * 4;
            int i = i4 * 16 + l15;
            uint2 ov;
            ov.x = pack2(o[et][i4][0], o[et][i4][1]);
            ov.y = pack2(o[et][i4][2], o[et][i4][3]);
            *reinterpret_cast<uint2*>(obuf + (size_t)(rb + i) * 1024 + hg * 128 + e0) = ov;
          }
        asm volatile("" ::: "memory");
#pragma unroll
        for (int dt = 0; dt < 4; ++dt) {
          f32x4 dc = *reinterpret_cast<const f32x4*>(DEC + dt * 16 + quad * 4);
#pragma unroll
          for (int et = 0; et < 2; ++et) S[dt][et] *= dc;
        }
#pragma unroll
        for (int kk = 0; kk < 2; ++kk)
#pragma unroll
          for (int dt = 0; dt < 4; ++dt) {
            bf16x8 kf = ldfrag(KdT, dt * 16 + l15, kk * 4 + quad, sx);
#pragma unroll
            for (int et = 0; et < 2; ++et) S[dt][et] = MFMA(kf, vt[et][kk], S[dt][et]);
          }
#pragma unroll
        for (int dt = 0; dt < 4; ++dt)
#pragma unroll
          for (int et = 0; et < 2; ++et) {
            int e = 32 * w + et * 16 + l15, d0 = dt * 16 + quad * 4;
            uint2 ov;
            ov.x = pack2(S[dt][et][0], S[dt][et][1]);
            ov.y = pack2(S[dt][et][2], S[dt][et][3]);
            *reinterpret_cast<uint2*>(ST + e * 128 + (((d0 >> 3) ^ sx) << 4) + (d0 & 7) * 2) = ov;
          }
      }
      __syncthreads();
      stage_chunk(Qs, Ks, KdT, VT, LRb, tid, rq0, rq1, rk0, rk1, rv0, rv1, rv2, rv3, rl, !gla, dir, ld);
      {
        if (gla) {
          bf16x8 afr = (bf16x8){0, 0, 0, 0, 0, 0, 0, 0};
          if (quad < 2) afr = *reinterpret_cast<const bf16x8*>(&rl);
#pragma unroll
          for (int dt = 0; dt < 4; ++dt) {
            f32x4 z = MFMA(afr, wafr[dt], ((f32x4){0.f, 0.f, 0.f, 0.f}));
#pragma unroll
            for (int j = 0; j < 4; ++j) {
              float zz = z[j] + bav[dt];
              gv[dt][j] = (fminf(zz, 0.f) - __logf(1.f + __expf(-fabsf(zz)))) * (1.f / 16.f);
            }
          }
#pragma unroll
          for (int dt = 0; dt < 4; ++dt) {
            gv[dt][1] += gv[dt][0];
            gv[dt][2] += gv[dt][1];
            gv[dt][3] += gv[dt][2];
            const float T = gv[dt][3];
            const float x1 = __shfl_up(T, 16, 64), x2 = __shfl_up(T, 32, 64), x3 = __shfl_up(T, 48, 64);
            const float E = (quad >= 1 ? x1 : 0.f) + (quad >= 2 ? x2 : 0.f) + (quad >= 3 ? x3 : 0.f);
            Eq[dt] = E;
            const float Wt = __shfl(E + T, 48 + l15, 64);
            if (quad == 0) TOT[w * 64 + dt * 16 + l15] = Wt;
          }
        } else {
#pragma unroll
          for (int dt = 0; dt < 4; ++dt) {
#pragma unroll
            for (int j = 0; j < 4; ++j) gv[dt][j] = ld * (float)(j + 1);
            Eq[dt] = ld * (float)(4 * quad);
          }
        }
      }
      __syncthreads();
    }
#undef PREFETCH
    if (!sample) {
      int lo_ = quad * 512 + 32 * w + l15;
      asm volatile("" : "+v"(lo_));
      float* dp = p.out + (gla ? OFF_SG : OFF_SR) + (size_t)((b * 2 + dir) * 4 + hh) * 8192 + lo_;
#pragma unroll
      for (int dt = 0; dt < 4; ++dt)
#pragma unroll
        for (int et = 0; et < 2; ++et)
#pragma unroll
          for (int jj = 0; jj < 4; ++jj)
            dp[dt * 2048 + jj * 128 + et * 16] = S[dt][et][jj];
    }
  }
}

__device__ void mix_phase(const P& p, int bid, int nb) {
  const int tid_ = opaque_tid();
  const int lane = tid_ & 63, wid = tid_ >> 6;
  const int col0 = lane * 16, hg = lane >> 3;
  const int nw = nb * 4;
  const int zoff = 1024 + (hg < 4 ? col0 : col0 + 1024);
  float gwv[16];
#pragma unroll
  for (int i = 0; i < 16; ++i) gwv[i] = (hg < 4) ? 1.f : p.gla_nw[(col0 & 127) + i];
  for (int r0 = bid * 4 + wid; r0 < NROWS / 2; r0 += nw) {
    uint4 f0[2], f1[2], b0[2], b1[2], z0[2], z1[2];
#pragma unroll
    for (int u = 0; u < 2; ++u) {
      const int row = r0 + u * (NROWS / 2);
      const uint4* pf = reinterpret_cast<const uint4*>(p.of + (size_t)row * 1024 + col0);
      const uint4* pb = reinterpret_cast<const uint4*>(p.ob + (size_t)row * 1024 + col0);
      const uint4* pz = reinterpret_cast<const uint4*>(p.proj + (size_t)row * NPROJ + zoff);
      f0[u] = pf[0]; f1[u] = pf[1]; b0[u] = pb[0]; b1[u] = pb[1]; z0[u] = pz[0]; z1[u] = pz[1];
    }
#pragma unroll
    for (int u = 0; u < 2; ++u) {
      const int row = r0 + u * (NROWS / 2);
      const u32 fw[8] = {f0[u].x, f0[u].y, f0[u].z, f0[u].w, f1[u].x, f1[u].y, f1[u].z, f1[u].w};
      const u32 bw[8] = {b0[u].x, b0[u].y, b0[u].z, b0[u].w, b1[u].x, b1[u].y, b1[u].z, b1[u].w};
      const u32 zw[8] = {z0[u].x, z0[u].y, z0[u].z, z0[u].w, z1[u].x, z1[u].y, z1[u].z, z1[u].w};
      float o[16];
      float s1 = 0.f;
#pragma unroll
      for (int i = 0; i < 8; ++i) {
        o[2 * i] = bflo(fw[i]) + bflo(bw[i]);
        o[2 * i + 1] = bfhi(fw[i]) + bfhi(bw[i]);
        s1 += o[2 * i] + o[2 * i + 1];
      }
      s1 += __shfl_xor(s1, 1, 64);
      s1 += __shfl_xor(s1, 2, 64);
      s1 += __shfl_xor(s1, 4, 64);
      const float mu = (hg < 4) ? s1 * (1.f / 128.f) : 0.f;
      float s2 = 0.f;
#pragma unroll
      for (int i = 0; i < 16; ++i) { float dlt = o[i] - mu; s2 += dlt * dlt; }
      s2 += __shfl_xor(s2, 1, 64);
      s2 += __shfl_xor(s2, 2, 64);
      s2 += __shfl_xor(s2, 4, 64);
      const float rs = rsqrtf(s2 * (1.f / 128.f) + EPS);
      u32 ow[8];
#pragma unroll
      for (int i = 0; i < 8; ++i) {
        float za = bflo(zw[i]), zb = bfhi(zw[i]);
        float ya = (o[2 * i] - mu) * rs * gwv[2 * i] * (za * __builtin_amdgcn_rcpf(1.f + __expf(-za)));
        float yb = (o[2 * i + 1] - mu) * rs * gwv[2 * i + 1] * (zb * __builtin_amdgcn_rcpf(1.f + __expf(-zb)));
        ow[i] = pack2(ya, yb);
      }
      uint4* po = reinterpret_cast<uint4*>(p.h + (size_t)row * 1024 + col0);
      po[0] = make_uint4(ow[0], ow[1], ow[2], ow[3]);
      po[1] = make_uint4(ow[4], ow[5], ow[6], ow[7]);
    }
  }
}

__device__ void final_phase(const P& p, int bid, int nb) {
  const int tid_ = opaque_tid();
  const int lane = tid_ & 63, wid = tid_ >> 6;
  const int nw = nb * 4;
  float4 fw[4];
#pragma unroll
  for (int i = 0; i < 4; ++i) fw[i] = reinterpret_cast<const float4*>(p.fnw)[lane + 64 * i];
  for (int r0 = bid * 4 + wid; r0 < NROWS / 2; r0 += nw) {
    float4 v[2][4];
#pragma unroll
    for (int u = 0; u < 2; ++u)
#pragma unroll
      for (int i = 0; i < 4; ++i)
        v[u][i] = reinterpret_cast<const float4*>(p.out + (size_t)(r0 + u * (NROWS / 2)) * 1024)[lane + 64 * i];
#pragma unroll
    for (int u = 0; u < 2; ++u) {
      float4* yr = reinterpret_cast<float4*>(p.out + (size_t)(r0 + u * (NROWS / 2)) * 1024);
      float ss = 0.f;
#pragma unroll
      for (int i = 0; i < 4; ++i)
        ss += v[u][i].x * v[u][i].x + v[u][i].y * v[u][i].y + v[u][i].z * v[u][i].z + v[u][i].w * v[u][i].w;
      ss = wave_sum(ss);
      const float r = rsqrtf(ss * (1.f / 1024.f) + EPS);
#pragma unroll
      for (int i = 0; i < 4; ++i)
        yr[lane + 64 * i] = make_float4(v[u][i].x * r * fw[i].x, v[u][i].y * r * fw[i].y, v[u][i].z * r * fw[i].z,
                                        v[u][i].w * r * fw[i].w);
    }
  }
}

template <int PH>
__device__ __forceinline__ void run_phase(const P& p, int bid, int nb, char* smem) {
  if (PH == 0) phase0(p, bid, nb, smem);
  if (PH == 1) phase1(p, bid, nb);
  if (PH == 2) gemm_phase<1>(p, bid & 7, bid >> 3, nb >> 3, smem, 0);
  if (PH == 3) rec_phase(p, smem, bid, nullptr);
  if (PH == 4) mix_phase(p, bid, nb);
  if (PH == 5) gemm_phase<2>(p, bid & 7, bid >> 3, nb >> 3, smem, 2);
  if (PH == 6) final_phase(p, bid, nb);
}

#if MULTI_LAUNCH
template <int PH>
__global__ void __launch_bounds__(256, 2) phase_kernel(P p) {
  extern __shared__ __attribute__((aligned(16))) char smem[];
  run_phase<PH>(p, blockIdx.x, gridDim.x, smem);
}
#else
__global__ void __launch_bounds__(256, 2) mega_kernel(P p) {
  extern __shared__ __attribute__((aligned(16))) char smem[];
  __shared__ uint4 xb_words;
  if (threadIdx.x == 0) xb_words = make_uint4(0u, 0u, 0u, 0u);
  __syncthreads();
  XcdBarrier xb = xcd_barrier_post(p.bar, (volatile LAS unsigned*)&xb_words);
  const int bid = blockIdx.x, nb = gridDim.x;
  run_phase<0>(p, bid, nb, smem);
  xcd_barrier(xb);
  run_phase<1>(p, bid, nb, smem);
  xcd_barrier(xb);
  {
    const bool heavy = rec_is_heavy(bid);
    const int g_ = bid & 7, l_ = bid >> 3;
    const bool hgla = (l_ >> 1) >= 4;
    unsigned* gq = p.bar + 3520 + g_ * 64;
    int* sWork = reinterpret_cast<int*>(smem + 71168);
    bool scanned = !heavy;
#pragma nounroll
    for (;;) {
      int kind = 0, tm = 4, mtx = 0, ntx = 0, item = 0, post = 0;
      unsigned* gate = nullptr;
      unsigned gtarget = 0u;
      __syncthreads();
      if (threadIdx.x == 0) {
        int go = 0;
        if (!scanned) go = (xb_ld(gq + 16) >= (hgla ? 144u : 272u)) ? 1 : 0;
        sWork[1] = go;
        sWork[0] = go ? 0 : (int)xb_add(gq + 16, 1u);
      }
      __syncthreads();
      const int go_ = __builtin_amdgcn_readfirstlane(sWork[1]);
      const int wk = __builtin_amdgcn_readfirstlane(sWork[0]);
      if (go_) {
        kind = 1; item = (g_ << 4) | l_; scanned = true;
        gate = hgla ? (gq + 32) : (gq + 36); gtarget = hgla ? 144u : 128u;
      } else if (wk >= 664) {
        if (scanned) break;
        continue;
      } else if (wk < 144) { const int j_ = wk >> 4; ntx = (j_ < 8) ? 12 + j_ : 24; mtx = 64 + 16 * g_ + (wk & 15); tm = 3; post = 32; }
      else if (wk < 272) { const int u_ = wk - 144; ntx = u_ >> 4; mtx = 64 + 16 * g_ + (u_ & 15); tm = 3; post = 36; }
      else if (wk < 408) { const int u_ = wk - 272, j_ = u_ >> 3; ntx = (j_ < 8) ? j_ : (j_ < 16 ? j_ + 4 : 24); mtx = 8 * g_ + (u_ & 7); tm = 3; post = 40; }
      else if (wk >= 456 && wk < 520) { kind = 1; const int r_ = wk - 456; item = 128 + (((4 * g_ + (r_ >> 4)) << 4) | (r_ & 15)); gate = gq + 40; gtarget = 136u; }
      else {
        const int v_ = (wk < 456) ? wk - 408 : wk - 520 + 48;
        if (v_ < 64) { const int j_ = v_ >> 3; ntx = (j_ < 4) ? 8 + j_ : 16 + j_; mtx = 8 * g_ + (v_ & 7); }
        else { const int u_ = v_ - 64, j_ = u_ >> 4; ntx = (j_ < 4) ? 8 + j_ : 16 + j_; mtx = 64 + 16 * g_ + (u_ & 15); }
      }
      if (kind == 0) gemm_phase<1>(p, g_, 0, 1, smem, tm, mtx, ntx);
      else rec_phase(p, smem, item, gate, gtarget);
      if (post) {
        asm volatile("s_waitcnt vmcnt(0)" ::: "memory");
        __syncthreads();
        if (threadIdx.x == 0) xb_add(gq + post, 1u);
      }
    }
  }
  xcd_barrier(xb);
  run_phase<4>(p, bid, nb, smem);
  xcd_barrier(xb);
  run_phase<5>(p, bid, nb, smem);
}
#endif

extern "C" void kernel_launch(void* const* d_in, const int* in_sizes, int n_in, void* d_out, int out_size,
                              void* d_ws, size_t ws_size, hipStream_t stream) {
  constexpr size_t WS_MOD = 0, WS_ROPE = 131072, WS_WTIN = 262144, WS_WTOUT = WS_WTIN + 6553600,
                   WS_H = WS_WTOUT + 2097152, WS_PROJ = WS_H + 50331648, WS_END = WS_PROJ + (size_t)NROWS * NPROJ * 2;
  if (ws_size < WS_END + 32768 || n_in != 15) { fprintf(stderr, "kernel_launch: bad ws/n_in\n"); return; }
  P p{};
  p.x_prompt = (const float*)d_in[0]; p.x_sample = (const float*)d_in[1]; p.c = (const float*)d_in[2];
  p.state_ret = (const float*)d_in[3]; p.state_gla = (const float*)d_in[4]; p.c_ctx = (const float*)d_in[5];
  p.w_mod = (const float*)d_in[6]; p.b_mod = (const float*)d_in[7]; p.w_in = (const float*)d_in[8];
  p.ret_ld = (const float*)d_in[9]; p.gla_wa = (const float*)d_in[10]; p.gla_ba = (const float*)d_in[11];
  p.gla_nw = (const float*)d_in[12]; p.w_out = (const float*)d_in[13]; p.fnw = (const float*)d_in[14];
  p.out = (float*)d_out;
  char* ws = (char*)d_ws;
  p.mod = (float*)(ws + WS_MOD); p.rope = (float*)(ws + WS_ROPE); p.bar = (unsigned*)(ws + 114688); p.rowss = (float*)(ws + 147456); p.mcnt = (unsigned*)(ws + 245760);
  p.wt_in = (u16*)(ws + WS_WTIN); p.wt_out = (u16*)(ws + WS_WTOUT);
  p.h = (u16*)(ws + WS_H); p.proj = (u16*)(ws + WS_PROJ); p.watab = (uint4*)(ws + WS_END);
  p.of = (u16*)d_out; p.ob = (u16*)d_out + (size_t)NROWS * 1024;
  (void)hipMemsetAsync(ws, 0, 262144, stream);
#if MULTI_LAUNCH
  static int inited = 0;
  if (!inited) {
    hipFuncSetAttribute((const void*)phase_kernel<0>, hipFuncAttributeMaxDynamicSharedMemorySize, LDS_BYTES);
    hipFuncSetAttribute((const void*)phase_kernel<1>, hipFuncAttributeMaxDynamicSharedMemorySize, LDS_BYTES);
    hipFuncSetAttribute((const void*)phase_kernel<2>, hipFuncAttributeMaxDynamicSharedMemorySize, LDS_BYTES);
    hipFuncSetAttribute((const void*)phase_kernel<3>, hipFuncAttributeMaxDynamicSharedMemorySize, LDS_BYTES);
    hipFuncSetAttribute((const void*)phase_kernel<4>, hipFuncAttributeMaxDynamicSharedMemorySize, LDS_BYTES);
    hipFuncSetAttribute((const void*)phase_kernel<5>, hipFuncAttributeMaxDynamicSharedMemorySize, LDS_BYTES);
    hipFuncSetAttribute((const void*)phase_kernel<6>, hipFuncAttributeMaxDynamicSharedMemorySize, LDS_BYTES);
    inited = 1;
  }
  const int G = 512;
  phase_kernel<0><<<G, 256, LDS_BYTES, stream>>>(p);
  phase_kernel<1><<<G, 256, LDS_BYTES, stream>>>(p);
  phase_kernel<2><<<G, 256, LDS_BYTES, stream>>>(p);
  phase_kernel<3><<<G, 256, LDS_BYTES, stream>>>(p);
  phase_kernel<4><<<G, 256, LDS_BYTES, stream>>>(p);
  phase_kernel<5><<<G, 256, LDS_BYTES, stream>>>(p);
  phase_kernel<6><<<G, 256, LDS_BYTES, stream>>>(p);
#else
  static int grid_blocks = 0;
  if (!grid_blocks) {
    int dev = 0, cus = 0, per_cu = 0;
    hipGetDevice(&dev);
    hipDeviceGetAttribute(&cus, hipDeviceAttributeMultiprocessorCount, dev);
    hipFuncSetAttribute((const void*)mega_kernel, hipFuncAttributeMaxDynamicSharedMemorySize, LDS_BYTES);
    hipOccupancyMaxActiveBlocksPerMultiprocessor(&per_cu, (const void*)mega_kernel, 256, LDS_BYTES);
    (void)per_cu;
    per_cu = 2;
    grid_blocks = cus * per_cu;
  }
  void* args[] = {&p};
  hipError_t e = hipLaunchCooperativeKernel((const void*)mega_kernel, dim3(grid_blocks), dim3(256), args, LDS_BYTES, stream);
  if (e != hipSuccess) fprintf(stderr, "cooperative launch failed: %s (grid %d)\n", hipGetErrorString(e), grid_blocks);
#endif
}
```
